# Optimizing an MI355X kernel written in HIP

```python
import math
import jax, jax.numpy as jnp
from jax import lax
import numpy as np

D_MODEL = 2048
BATCH = 4
SEQ = 8192
DEPTH = 1

N_META = 16
SSM_WIDTH = D_MODEL // 2
SSM_GROUP = 16
SSM_GROUPS = SSM_WIDTH // SSM_GROUP
SSM_STATE = 64
DT_MIN = 1e-3
DT_MAX = 1e-1
HEAD_DIM = 128
N_HEADS = (D_MODEL // 2) // HEAD_DIM
N_KV_HEADS = 2
ATTN_WIDTH = N_HEADS * HEAD_DIM
KV_WIDTH = N_KV_HEADS * HEAD_DIM
WINDOW = 128
BLOCK = 128
N_BRANCH = 2
IN_COLS = SSM_WIDTH + ATTN_WIDTH + 2 * KV_WIDTH + N_BRANCH * D_MODEL
PEER_HEADS = 8
PEER_KEYS = 128
PEER_N_EXPERTS = PEER_KEYS * PEER_KEYS
PEER_QDIM = 256
PEER_TOPK = 16
PEER_TOKEN_BLOCK = 256
NORM_EPS = 1e-6
NEG_INF = -1e30

kernel_name = "hybrid_s5_swa_peer_encoder"


def rms_norm(x, g):
    xf = x.astype(jnp.float32)
    y = xf * lax.rsqrt(jnp.mean(xf * xf, axis=-1, keepdims=True) + NORM_EPS)
    return (y * g.astype(jnp.float32)).astype(x.dtype)


def _s5_discretize(lam_re, lam_im, log_dt, b_re, b_im):
    f32 = jnp.float32
    dt = jnp.exp(log_dt.astype(f32))[:, None]
    lr = lam_re.astype(f32)
    li = lam_im.astype(f32)
    mag = jnp.exp(lr * dt)
    a_re = mag * jnp.cos(li * dt)
    a_im = mag * jnp.sin(li * dt)
    den = lr * lr + li * li
    nr = a_re - 1.0
    ni = a_im
    coef_re = (nr * lr + ni * li) / den
    coef_im = (ni * lr - nr * li) / den
    br = b_re.astype(f32)
    bi = b_im.astype(f32)
    bb_re = coef_re[..., None] * br - coef_im[..., None] * bi
    bb_im = coef_re[..., None] * bi + coef_im[..., None] * br
    return a_re, a_im, bb_re, bb_im


def _complex_linear_combine(e1, e2):
    a1r, a1i, b1r, b1i = e1
    a2r, a2i, b2r, b2i = e2
    ar = a2r * a1r - a2i * a1i
    ai = a2r * a1i + a2i * a1r
    br = a2r * b1r - a2i * b1i + b2r
    bi = a2r * b1i + a2i * b1r + b2i
    return ar, ai, br, bi


def _s5_direction(u_g, a_re, a_im, bb_re, bb_im, c_re, c_im, reverse):
    bu_re = jnp.einsum('lgc,gpc->lgp', u_g, bb_re)
    bu_im = jnp.einsum('lgc,gpc->lgp', u_g, bb_im)
    ar = jnp.broadcast_to(a_re, bu_re.shape)
    ai = jnp.broadcast_to(a_im, bu_re.shape)
    _, _, h_re, h_im = lax.associative_scan(
        _complex_linear_combine, (ar, ai, bu_re, bu_im), reverse=reverse, axis=0)
    cr = c_re.astype(jnp.float32)
    ci = c_im.astype(jnp.float32)
    return jnp.einsum('lgp,gcp->lgc', h_re, cr) - jnp.einsum('lgp,gcp->lgc', h_im, ci)


def s5_mixer(u, lam_re, lam_im, log_dt, b_re, b_im, c_re, c_im, d_skip, w_glu, b_glu):
    f32 = jnp.float32
    L = u.shape[1]
    disc = [_s5_discretize(lam_re[r], lam_im[r], log_dt[r], b_re[r], b_im[r]) for r in range(2)]

    def per_seq(u_seq):
        ug = u_seq.astype(f32).reshape(L, SSM_GROUPS, SSM_GROUP)
        y_fwd = _s5_direction(ug, *disc[0], c_re[0], c_im[0], False)
        y_bwd = _s5_direction(ug, *disc[1], c_re[1], c_im[1], True)
        return (y_fwd + y_bwd).reshape(L, SSM_WIDTH)

    uf = u.astype(f32)
    y = lax.map(per_seq, uf) + d_skip.astype(f32) * uf
    y = jax.nn.gelu(y)
    y = y * jax.nn.sigmoid(y @ w_glu.astype(f32) + b_glu.astype(f32))
    return y.astype(u.dtype)


def _to_layout(t):
    pad = jnp.zeros((t.shape[0], BLOCK - N_META) + t.shape[2:], t.dtype)
    return jnp.concatenate([t[:, :N_META], pad, t[:, N_META:]], axis=1)


def _from_layout(t):
    return jnp.concatenate([t[:, :N_META], t[:, BLOCK:]], axis=1)


def _band(t, nb):
    tb = t.reshape((t.shape[0], nb, BLOCK) + t.shape[2:])
    widths = [(0, 0), (1, 1)] + [(0, 0)] * (tb.ndim - 2)
    tb = jnp.pad(tb, widths)
    return jnp.concatenate([tb[:, :-2], tb[:, 1:-1], tb[:, 2:]], axis=2)


def _alibi_slopes():
    s = 2.0 ** (-8.0 * np.arange(1, N_HEADS + 1) / N_HEADS)
    return jnp.asarray(s, dtype=jnp.float32)


def windowed_gqa(q, k, v, sink):
    f32 = jnp.float32
    bsz = q.shape[0]
    grp = N_HEADS // N_KV_HEADS
    qp = _to_layout(q * (HEAD_DIM ** -0.5))
    kp = _to_layout(k)
    vp = _to_layout(v)
    Lp = qp.shape[1]
    nb = Lp // BLOCK
    idx = jnp.arange(Lp, dtype=jnp.int32)
    is_meta = idx < N_META
    is_real = idx >= BLOCK
    valid = is_meta | is_real
    pos = jnp.where(is_real, idx - BLOCK + N_META, idx)

    qb = qp.reshape(bsz, nb, BLOCK, N_KV_HEADS, grp, HEAD_DIM)
    kb = _band(kp, nb)
    vb = _band(vp, nb)
    pos_q = pos.reshape(nb, BLOCK)
    pos_b = _band(pos[None], nb)[0]
    valid_b = _band(valid[None], nb)[0]
    meta_b = _band(is_meta[None], nb)[0]
    dist = jnp.abs(pos_q[:, :, None] - pos_b[:, None, :]).astype(f32)
    allowed = valid_b[:, None, :] & (~meta_b[:, None, :]) & (dist <= WINDOW)
    slopes = _alibi_slopes().reshape(N_KV_HEADS, grp)
    bias = -slopes[None, :, :, None, None] * dist[:, None, None]

    s_band = jnp.einsum('bnqkgd,bnskd->bnkgqs', qb, kb, preferred_element_type=f32)
    s_band = jnp.where(allowed[:, None, None], s_band + bias, NEG_INF)
    k_meta = k[:, :N_META]
    v_meta = v[:, :N_META]
    s_meta = jnp.einsum('bnqkgd,bmkd->bnkgqm', qb, k_meta, preferred_element_type=f32)
    sink_l = jnp.broadcast_to(sink.astype(f32).reshape(N_KV_HEADS, grp)[None, None, :, :, None, None],
                              s_meta.shape[:-1] + (1,))
    p = jax.nn.softmax(jnp.concatenate([s_band, s_meta, sink_l], axis=-1), axis=-1)
    p_band = p[..., :3 * BLOCK].astype(v.dtype)
    p_meta = p[..., 3 * BLOCK:3 * BLOCK + N_META].astype(v.dtype)
    out = (jnp.einsum('bnkgqs,bnskd->bnqkgd', p_band, vb)
           + jnp.einsum('bnkgqm,bmkd->bnqkgd', p_meta, v_meta))
    out = out.reshape(bsz, Lp, ATTN_WIDTH)
    return _from_layout(out)


def peer_ffn(h, w_q, sub_k1, sub_k2, u_emb, v_emb):
    f32 = jnp.float32
    bsz, L, D = h.shape
    ht = h.reshape(-1, D)
    T = ht.shape[0]
    half = PEER_QDIM // 2
    q = (ht @ w_q).reshape(T, PEER_HEADS, 2, half)
    s1 = jnp.einsum('thd,hnd->thn', q[:, :, 0], sub_k1, preferred_element_type=f32)
    s2 = jnp.einsum('thd,hnd->thn', q[:, :, 1], sub_k2, preferred_element_type=f32)
    v1, i1 = lax.top_k(s1, PEER_TOPK)
    v2, i2 = lax.top_k(s2, PEER_TOPK)
    cand = (v1[..., :, None] + v2[..., None, :]).reshape(T, PEER_HEADS, PEER_TOPK * PEER_TOPK)
    sc, ci = lax.top_k(cand, PEER_TOPK)
    e1 = jnp.take_along_axis(i1, ci // PEER_TOPK, axis=-1)
    e2 = jnp.take_along_axis(i2, ci % PEER_TOPK, axis=-1)
    eidx = e1 * PEER_KEYS + e2
    gate = jax.nn.softmax(sc, axis=-1)

    pad = (-T) % PEER_TOKEN_BLOCK
    nc = (T + pad) // PEER_TOKEN_BLOCK
    ht_p = jnp.pad(ht, ((0, pad), (0, 0))).reshape(nc, PEER_TOKEN_BLOCK, D)
    e_p = jnp.pad(eidx, ((0, pad), (0, 0), (0, 0))).reshape(nc, PEER_TOKEN_BLOCK, PEER_HEADS, PEER_TOPK)
    g_p = jnp.pad(gate, ((0, pad), (0, 0), (0, 0))).reshape(nc, PEER_TOKEN_BLOCK, PEER_HEADS, PEER_TOPK)

    def block(args):
        hc, ec, gc = args
        u = jnp.take(u_emb, ec, axis=0)
        a = jnp.einsum('cd,chkd->chk', hc, u, preferred_element_type=f32)
        w = (gc * jax.nn.gelu(a)).astype(hc.dtype)
        vv = jnp.take(v_emb, ec, axis=0)
        return jnp.einsum('chk,chkd->cd', w, vv).astype(hc.dtype)

    out = lax.map(block, (ht_p, e_p, g_p))
    return out.reshape(-1, D)[:T].reshape(bsz, L, D)


def setup_inputs(seed: int = 0) -> dict:
    key = jax.random.key(seed)
    ks = jax.random.split(key, 28)
    f32 = jnp.float32

    def nrm(k, shape, scale):
        return jax.random.normal(k, shape, f32) * scale

    G, P, C = SSM_GROUPS, SSM_STATE, SSM_GROUP
    n = jnp.arange(P, dtype=f32)
    return {
        "x": nrm(ks[0], (BATCH, SEQ, D_MODEL), 1.0),
        "meta_tokens": nrm(ks[1], (N_META, D_MODEL), 1.0),
        "norm_mix": 1.0 + nrm(ks[2], (DEPTH, D_MODEL), 0.05),
        "w_in": nrm(ks[3], (DEPTH, D_MODEL, IN_COLS), D_MODEL ** -0.5),
        "b_gate": nrm(ks[4], (DEPTH, N_BRANCH * D_MODEL), 0.02),
        "ssm_lam_re": -0.5 + nrm(ks[5], (DEPTH, 2, G, P), 0.01),
        "ssm_lam_im": math.pi * n + nrm(ks[6], (DEPTH, 2, G, P), 0.01),
        "ssm_log_dt": jax.random.uniform(ks[7], (DEPTH, 2, G), f32, math.log(DT_MIN), math.log(DT_MAX)),
        "ssm_b_re": nrm(ks[8], (DEPTH, 2, G, P, C), (2.0 * C) ** -0.5),
        "ssm_b_im": nrm(ks[9], (DEPTH, 2, G, P, C), (2.0 * C) ** -0.5),
        "ssm_c_re": nrm(ks[10], (DEPTH, 2, G, C, P), 0.5),
        "ssm_c_im": nrm(ks[11], (DEPTH, 2, G, C, P), 0.5),
        "ssm_d": nrm(ks[12], (DEPTH, SSM_WIDTH), 1.0),
        "ssm_w_glu": nrm(ks[13], (DEPTH, SSM_WIDTH, SSM_WIDTH), SSM_WIDTH ** -0.5),
        "ssm_b_glu": nrm(ks[14], (DEPTH, SSM_WIDTH), 0.02),
        "attn_sink": nrm(ks[15], (DEPTH, N_HEADS), 1.0),
        "w_proj_ssm": nrm(ks[16], (DEPTH, SSM_WIDTH, D_MODEL), SSM_WIDTH ** -0.5),
        "w_proj_attn": nrm(ks[17], (DEPTH, ATTN_WIDTH, D_MODEL), ATTN_WIDTH ** -0.5),
        "w_out": nrm(ks[18], (DEPTH, D_MODEL, D_MODEL), D_MODEL ** -0.5),
        "norm_ffn": 1.0 + nrm(ks[19], (DEPTH, D_MODEL), 0.05),
        "peer_w_q": nrm(ks[20], (DEPTH, D_MODEL, PEER_HEADS * PEER_QDIM), D_MODEL ** -0.5),
        "peer_k1": nrm(ks[21], (DEPTH, PEER_HEADS, PEER_KEYS, PEER_QDIM // 2), (PEER_QDIM // 2) ** -0.5),
        "peer_k2": nrm(ks[22], (DEPTH, PEER_HEADS, PEER_KEYS, PEER_QDIM // 2), (PEER_QDIM // 2) ** -0.5),
        "peer_u": nrm(ks[23], (DEPTH, PEER_N_EXPERTS, D_MODEL), D_MODEL ** -0.5),
        "peer_v": nrm(ks[24], (DEPTH, PEER_N_EXPERTS, D_MODEL), 0.5),
        "norm_final": 1.0 + nrm(ks[25], (D_MODEL,), 0.05),
    }


def reference(x, meta_tokens, norm_mix, w_in, b_gate, ssm_lam_re, ssm_lam_im, ssm_log_dt,
              ssm_b_re, ssm_b_im, ssm_c_re, ssm_c_im, ssm_d, ssm_w_glu, ssm_b_glu, attn_sink,
              w_proj_ssm, w_proj_attn, w_out, norm_ffn, peer_w_q, peer_k1, peer_k2, peer_u,
              peer_v, norm_final):
    bsz = x.shape[0]
    meta = jnp.broadcast_to(meta_tokens.astype(x.dtype)[None], (bsz, N_META, D_MODEL))
    hs = jnp.concatenate([meta, x], axis=1)
    L = hs.shape[1]
    splits = [SSM_WIDTH, SSM_WIDTH + ATTN_WIDTH, SSM_WIDTH + ATTN_WIDTH + KV_WIDTH,
              SSM_WIDTH + ATTN_WIDTH + 2 * KV_WIDTH]
    for l in range(DEPTH):
        h = rms_norm(hs, norm_mix[l])
        z = h @ w_in[l]
        u_ssm, q, k, v, gates = jnp.split(z, splits, axis=-1)
        y_a = s5_mixer(u_ssm, ssm_lam_re[l], ssm_lam_im[l], ssm_log_dt[l], ssm_b_re[l], ssm_b_im[l],
                       ssm_c_re[l], ssm_c_im[l], ssm_d[l], ssm_w_glu[l], ssm_b_glu[l])
        y_b = windowed_gqa(q.reshape(bsz, L, N_HEADS, HEAD_DIM),
                           k.reshape(bsz, L, N_KV_HEADS, HEAD_DIM),
                           v.reshape(bsz, L, N_KV_HEADS, HEAD_DIM), attn_sink[l])
        g = jax.nn.sigmoid((gates + b_gate[l]).astype(jnp.float32)).astype(hs.dtype)
        g = g.reshape(bsz, L, N_BRANCH, D_MODEL)
        merged = g[:, :, 0] * (y_a @ w_proj_ssm[l]) + g[:, :, 1] * (y_b @ w_proj_attn[l])
        hs = hs + merged @ w_out[l]
        hs = hs + peer_ffn(rms_norm(hs, norm_ffn[l]), peer_w_q[l], peer_k1[l], peer_k2[l],
                           peer_u[l], peer_v[l])
    hs = rms_norm(hs, norm_final)
    return hs[:, N_META:]
```

```cpp
#include <hip/hip_runtime.h>
#include <hip/hip_cooperative_groups.h>
#include <cstdio>
#include <cstdint>
namespace cg = cooperative_groups;

#ifndef DBG
#define DBG 0
#endif
#ifndef REP_MASK
#define REP_MASK 0
#endif
#ifndef MK_N_LAUNCHES
#define MK_N_LAUNCHES 1
#endif

#define LAS __attribute__((address_space(3)))
typedef unsigned short bf16_t;
typedef short bf16x8 __attribute__((ext_vector_type(8)));
typedef short s16x4 __attribute__((ext_vector_type(4)));
typedef float f32x4 __attribute__((ext_vector_type(4)));
typedef float f32x2 __attribute__((ext_vector_type(2)));
typedef float f32x16 __attribute__((ext_vector_type(16)));
typedef unsigned u32x4 __attribute__((ext_vector_type(4)));
typedef unsigned u32x2 __attribute__((ext_vector_type(2)));
typedef unsigned u32x6 __attribute__((ext_vector_type(6)));
typedef float f32x32 __attribute__((ext_vector_type(32)));
typedef int i32x8 __attribute__((ext_vector_type(8)));
typedef int i32x4 __attribute__((ext_vector_type(4)));

constexpr int D_MODEL = 2048, BATCH = 4, SEQ = 8192, N_META = 16;
constexpr int TOK = BATCH * SEQ;
constexpr int MROWS = TOK + 256;
constexpr int IN_COLS = 6656;
constexpr int NCHUNK = TOK / 64;
constexpr int LDA_G = 1280;
constexpr float NORM_EPS = 1e-6f;
constexpr float LOG2E = 1.4426950408889634f;
constexpr int NTHREADS = 512, NWAVES = 8;
constexpr int LDS_BYTES = 163840;

constexpr size_t MiB = 1u << 20;
constexpr size_t WS_WIN = 1 * MiB;
constexpr size_t WS_DOTS = 1 * MiB;
constexpr size_t WS_WGLU = 27 * MiB;
constexpr size_t WS_WPS = 29 * MiB;
constexpr size_t WS_WPA = 33 * MiB;
constexpr size_t WS_WOUT = 37 * MiB;
constexpr size_t WS_WQ = 45 * MiB;
constexpr size_t WS_PK = 53 * MiB;
constexpr size_t WS_S5M = 54 * MiB;
constexpr size_t WS_UMETA = 55 * MiB + 512 * 1024;

constexpr size_t WS_UT = 56 * MiB;
constexpr size_t WS_VT = 80 * MiB;
constexpr size_t WS_ISU = 96 * MiB;
constexpr size_t WS_ISV = 97 * MiB;
constexpr size_t WS_HA8 = 100 * MiB;
constexpr size_t WS_YB8 = 100 * MiB;
constexpr size_t WS_YA8 = 132 * MiB;
constexpr size_t WS_WP8 = 179 * MiB;
constexpr size_t WS_WG8 = 166 * MiB;
constexpr size_t WS_KTAB = 184 * MiB;
constexpr size_t WS_PT = 188 * MiB;
constexpr size_t WS_QT = 220 * MiB;
constexpr size_t WS_GATES = 252 * MiB;
constexpr size_t WS_QP = 252 * MiB;
constexpr size_t WS_EIDX = 380 * MiB;
constexpr size_t WS_EGATE = 396 * MiB;
constexpr size_t WS_HA = 508 * MiB;
constexpr size_t WS_M0 = 508 * MiB;
constexpr size_t WS_H2U = 508 * MiB;
constexpr size_t WS_AG = 638 * MiB;
constexpr size_t WS_YA = 638 * MiB;
constexpr size_t WS_MERGED = 638 * MiB;
constexpr size_t WS_X8G = 638 * MiB;
constexpr size_t WS_XSCL = 702 * MiB;
constexpr size_t WS_Q = 718 * MiB;
constexpr size_t WS_K = 782 * MiB;
constexpr size_t WS_V = 799 * MiB;
constexpr size_t WS_S = 816 * MiB;
constexpr size_t WS_YAPRE = 848 * MiB;
constexpr size_t WS_YB = 912 * MiB;
constexpr size_t WS_RSS = 976 * MiB;
constexpr size_t WS_END = 980 * MiB;

__device__ __forceinline__ unsigned cvt_pk_bf16(float lo, float hi) { unsigned r; asm volatile("s_nop 0\n\tv_cvt_pk_bf16_f32 %0, %1, %2" : "=v"(r) : "v"(lo), "v"(hi)); return r; }
__device__ __forceinline__ float bf_lo(unsigned u) { return __uint_as_float(u << 16); }
__device__ __forceinline__ float bf_hi(unsigned u) { return __uint_as_float(u & 0xffff0000u); }
__device__ __forceinline__ float wave_sum(float v) {
#pragma unroll
    for (int o = 1; o < 64; o <<= 1) v += __shfl_xor(v, o);
    return v;
}
__device__ __forceinline__ float sigmoidf_(float z) { return __builtin_amdgcn_rcpf(1.0f + __builtin_amdgcn_exp2f(-z * LOG2E)); }
__device__ __forceinline__ float gelu_tanh(float x) {
    const float z = x * (1.0f + 0.044715f * x * x);
    return x * __builtin_amdgcn_rcpf(1.0f + __builtin_amdgcn_exp2f(-2.0f * 0.7978845608028654f * LOG2E * z));
}
__device__ __forceinline__ int tid_fresh() { int t = threadIdx.x; asm volatile("" : "+v"(t)); return t; }
#define LDS_WAIT() asm volatile("s_waitcnt lgkmcnt(0)" ::: "memory")
#define VM_WAIT() asm volatile("s_waitcnt vmcnt(0)" ::: "memory")

namespace pg {
constexpr int BM = 256, BK = 64, HALF = 128, HTB = HALF * BK * 2, NXCD = 8, WGM = 8;
__host__ __device__ __forceinline__ int lds_byte(int r, int c) { const int st = (r >> 4) * 2 + (c >> 5), rr = r & 15, cc = c & 31, ob = rr * 64 + cc * 2; return st * 1024 + (ob ^ (((ob >> 9) & 1) << 5)); }
__host__ __device__ __forceinline__ void stage_rc(int b, int& R, int& C) { const int st = b / 1024, sb = b % 1024, swz = sb ^ (((sb >> 9) & 1) << 5); R = (st >> 1) * 16 + swz / 64; C = (st & 1) * 32 + (swz % 64) / 2; }
__host__ __device__ __forceinline__ int perm32(int rho) { const int n = rho >> 4, i = rho & 15; return 8 * (i >> 2) + 4 * n + (i & 3); }

struct Unit { int pm, pn, grp; };
struct Desc {
    const char* A[2]; const char* B[2];
    long kA[2], kB[2];
    long hA[2], hB[2];
    long tA[2], tB[2];
    long gA[2], gB[2];
    int lda[2], ldb[2];
    int nt[2];
    int toep;
};
__host__ __device__ inline void desc_seg(Desc& d, int s, const void* A, int lda, long gA, const void* B, int ldb, long gB, int K) {
    d.A[s] = (const char*)A; d.B[s] = (const char*)B; d.lda[s] = lda; d.ldb[s] = ldb;
    d.kA[s] = BK * 2; d.kB[s] = BK * 2; d.hA[s] = (long)HALF * lda * 2; d.hB[s] = (long)HALF * ldb * 2; d.tA[s] = 2 * d.hA[s]; d.tB[s] = 2 * d.hB[s];
    d.gA[s] = gA; d.gB[s] = gB; d.nt[s] = K / BK;
}
struct StaticOrder {
    int nM, nN, nwg, G, c;
    __device__ void init(int M, int N, int G_, int c_) { nM = M / BM; nN = N / BM; nwg = nM * nN; G = G_; c = c_; }
    __device__ bool next(int i, Unit& u) const {
        const long L = (long)i * G + c; if (L >= nwg) return false;
        int wgid = (int)L; { const int q = nwg / NXCD, r = nwg % NXCD, xcd = wgid % NXCD, off = wgid / NXCD; wgid = (xcd < r ? xcd * (q + 1) : r * (q + 1) + (xcd - r) * q) + off; }
        const int nig = WGM * nN, gid = wgid / nig, fm = gid * WGM, gsz = (nM - fm) < WGM ? (nM - fm) : WGM;
        u.pm = fm + ((wgid % nig) % gsz); u.pn = (wgid % nig) / gsz; u.grp = 0; return true;
    }
};
struct GroupOrder {
    int nM, nN, ng, G, c;
    __device__ bool next(int i, Unit& u) const {
        const long L = (long)i * G + c; if (L >= (long)ng * nM * nN) return false;
        const int per = nM * nN; u.grp = (int)(L / per); const int r = (int)(L % per); u.pm = r / nN; u.pn = r % nN; return true;
    }
};

#define PG_SA(b, h) (((b) * 2 + (h)) * HTB)
#define PG_SB(b, h) ((4 + (b) * 2 + (h)) * HTB)
#define PG_STAGE(bufoff, gbase, v0, v1) do { \
        __builtin_amdgcn_global_load_lds((const unsigned*)((const char*)(gbase) + (v0)), (LAS unsigned*)(lds + (bufoff) + ldsw), 16, 0, 0); \
        __builtin_amdgcn_global_load_lds((const unsigned*)((const char*)(gbase) + (v1)), (LAS unsigned*)(lds + (bufoff) + ldsw + 8192), 16, 0, 0); } while (0)
typedef int v4i32_ __attribute__((ext_vector_type(4)));
#define PG_LD8(p) ({ const v4i32_ lo_ = *(const LAS v4i32_*)(p), hi_ = *(const LAS v4i32_*)((p) + 1024); __builtin_shufflevector(lo_, hi_, 0, 1, 2, 3, 4, 5, 6, 7); })
#define PG_LDA(dst, b, h) do { if constexpr (FP8) { _Pragma("unroll") for (int m = 0; m < 4; ++m) dst##8[m] = PG_LD8(lds + PG_SA(b, h) + aoff + m * 2048); } \
        else { _Pragma("unroll") for (int m = 0; m < 4; ++m) _Pragma("unroll") for (int k = 0; k < 2; ++k) dst[m][k] = *(const LAS bf16x8*)(lds + PG_SA(b, h) + aoff + m * 2048 + k * 1024); } } while (0)
#define PG_LDB(dst, b, h) do { if constexpr (FP8) { _Pragma("unroll") for (int n = 0; n < 2; ++n) dst##8[n] = PG_LD8(lds + PG_SB(b, h) + boff + n * 2048); } \
        else { _Pragma("unroll") for (int n = 0; n < 2; ++n) _Pragma("unroll") for (int k = 0; k < 2; ++k) dst[n][k] = *(const LAS bf16x8*)(lds + PG_SB(b, h) + boff + n * 2048 + k * 1024); } } while (0)
typedef int v8i32 __attribute__((ext_vector_type(8)));
#define PG_MMA(ai, bj, At, Bt) do { __builtin_amdgcn_s_setprio(1); \
        if constexpr (FP8) { _Pragma("unroll") for (int m = 0; m < 4; ++m) _Pragma("unroll") for (int n = 0; n < 2; ++n) \
            asm volatile("v_mfma_f32_16x16x128_f8f6f4 %0, %1, %2, %0" : "+v"(acc[ai][bj][m][n]) : "v"(Bt##8[n]), "v"(At##8[m])); } \
        else { _Pragma("unroll") for (int m = 0; m < 4; ++m) _Pragma("unroll") for (int n = 0; n < 2; ++n) _Pragma("unroll") for (int k = 0; k < 2; ++k) \
            acc[ai][bj][m][n] = __builtin_amdgcn_mfma_f32_16x16x32_bf16(Bt[n][k], At[m][k], acc[ai][bj][m][n], 0, 0, 0); } \
        __builtin_amdgcn_s_setprio(0); } while (0)
#define PG_WAIT_V(n) asm volatile("s_waitcnt vmcnt(" #n ")" ::: "memory")
#define PG_WAIT_L(n) asm volatile("s_waitcnt lgkmcnt(" #n ")" ::: "memory")
#define PG_BAR __builtin_amdgcn_s_barrier()
#define PG_SCHED __builtin_amdgcn_sched_barrier(0)

template <class Epi, class Order, bool TWO, bool FP8 = false>
__device__ __forceinline__ void gemm_phase(LAS unsigned char* lds, const Desc g, const Order& S, const Epi& E) {
    const int tid = tid_fresh(), wid = __builtin_amdgcn_readfirstlane(tid >> 6), lane = tid & 63, wr = wid >> 2, wc = wid & 3, fr = lane & 15, fq = lane >> 4;
    const int nt0 = g.nt[0], nt = nt0 + (TWO ? g.nt[1] : 0);
    unsigned voffA[2][2], voffB[2][2];
#pragma unroll
    for (int s = 0; s < (TWO ? 2 : 1); ++s)
#pragma unroll
        for (int i = 0; i < 2; ++i) { int R, C; stage_rc(tid * 16 + i * 8192, R, C); const int Rb = Epi::PERM ? ((R & ~31) + perm32(R & 31)) : R;
            voffA[s][i] = (unsigned)(R * g.lda[s] + C) * 2u;
            voffB[s][i] = (s == 0 && g.toep) ? (unsigned)(16 * Rb - 16 * C + 17 * (C & 15) + 768) * 2u : (unsigned)(Rb * g.ldb[s] + C) * 2u; }
    const unsigned ldsw = (unsigned)wid * 1024u;
    const int aoff = lds_byte(wr * 64 + fr, fq * 8), boff = lds_byte(wc * 32 + fr, fq * 8);
    Unit cur, nxt; int ui = 0;
    if (!S.next(0, cur)) return;
    f32x4 acc[2][2][4][2];
    bf16x8 At[4][2], B0[2][2], B1[2][2]; v8i32 At8[4], B08[2], B18[2]; (void)At; (void)B0; (void)B1; (void)At8; (void)B08; (void)B18;
    const char* cA0 = g.A[0] + (long)cur.pm * g.tA[0] + (long)cur.grp * g.gA[0];
    const char* cB0 = g.B[0] + (long)cur.pn * g.tB[0] + (long)cur.grp * g.gB[0];
    const char* cA1 = TWO ? g.A[1] + (long)cur.pm * g.tA[1] + (long)cur.grp * g.gA[1] : cA0;
    const char* cB1 = TWO ? g.B[1] + (long)cur.pn * g.tB[1] + (long)cur.grp * g.gB[1] : cB0;
    PG_STAGE(PG_SB(0, 0), cB0, voffB[0][0], voffB[0][1]); PG_STAGE(PG_SB(0, 1), cB0 + g.hB[0], voffB[0][0], voffB[0][1]);
    PG_STAGE(PG_SA(0, 0), cA0, voffA[0][0], voffA[0][1]); PG_STAGE(PG_SA(0, 1), cA0 + g.hA[0], voffA[0][0], voffA[0][1]);
    if (wr == 1) PG_BAR;
    PG_WAIT_V(2); PG_BAR;
    PG_STAGE(PG_SB(1, 0), cB0 + g.kB[0], voffB[0][0], voffB[0][1]); PG_STAGE(PG_SA(1, 0), cA0 + g.kA[0], voffA[0][0], voffA[0][1]); PG_STAGE(PG_SB(1, 1), cB0 + g.hB[0] + g.kB[0], voffB[0][0], voffB[0][1]);
    PG_WAIT_V(6); PG_BAR;
    __builtin_amdgcn_sched_barrier(0);
#pragma unroll
    for (int a = 0; a < 2; ++a)
#pragma unroll
        for (int b = 0; b < 2; ++b)
#pragma unroll
            for (int m = 0; m < 4; ++m)
#pragma unroll
                for (int n = 0; n < 2; ++n) acc[a][b][m][n] = (f32x4){0.f, 0.f, 0.f, 0.f};
    for (;;) {
        const bool has_next = S.next(ui + 1, nxt);
        const char* nA0 = has_next ? g.A[0] + (long)nxt.pm * g.tA[0] + (long)nxt.grp * g.gA[0] : cA0;
        const char* nB0 = has_next ? g.B[0] + (long)nxt.pn * g.tB[0] + (long)nxt.grp * g.gB[0] : cB0;
        for (int t = 0; t < nt; t += 2) {
            const bool last = (t == nt - 2);
            const int sc = (TWO && t >= nt0) ? 1 : 0, tl = t - (sc ? nt0 : 0);
            const char* a1 = (sc ? cA1 : cA0) + (long)(tl + 1) * (sc ? g.kA[1] : g.kA[0]);
            const long hA1 = sc ? g.hA[1] : g.hA[0];
            const unsigned va1_0 = sc ? voffA[1][0] : voffA[0][0], va1_1 = sc ? voffA[1][1] : voffA[0][1];
            int sn = 0; const char* a2; const char* b2;
            if (last) { a2 = nA0; b2 = nB0; }
            else { const int t2 = t + 2; sn = (TWO && t2 >= nt0) ? 1 : 0; const int tl2 = t2 - (sn ? nt0 : 0); a2 = (sn ? cA1 : cA0) + (long)tl2 * (sn ? g.kA[1] : g.kA[0]); b2 = (sn ? cB1 : cB0) + (long)tl2 * (sn ? g.kB[1] : g.kB[0]); }
            const char* a3 = a2 + (sn ? g.kA[1] : g.kA[0]); const char* b3 = b2 + (sn ? g.kB[1] : g.kB[0]);
            const long hA2 = sn ? g.hA[1] : g.hA[0], hB2 = sn ? g.hB[1] : g.hB[0];
            const unsigned va2_0 = sn ? voffA[1][0] : voffA[0][0], va2_1 = sn ? voffA[1][1] : voffA[0][1];
            const unsigned vb2_0 = sn ? voffB[1][0] : voffB[0][0], vb2_1 = sn ? voffB[1][1] : voffB[0][1];
            PG_LDB(B0, 0, 0); PG_LDB(B1, 0, 1); PG_SCHED; PG_LDA(At, 0, 0); PG_STAGE(PG_SA(1, 1), a1 + hA1, va1_0, va1_1);
            PG_WAIT_V(8); PG_WAIT_L(0); PG_BAR; PG_MMA(0, 0, At, B0); PG_MMA(0, 1, At, B1); PG_BAR; PG_SCHED;
            PG_LDA(At, 0, 1); PG_STAGE(PG_SB(0, 0), b2, vb2_0, vb2_1); PG_STAGE(PG_SB(0, 1), b2 + hB2, vb2_0, vb2_1); PG_STAGE(PG_SA(0, 0), a2, va2_0, va2_1);
            PG_WAIT_V(8); PG_WAIT_L(0); PG_BAR; PG_MMA(1, 0, At, B0); PG_MMA(1, 1, At, B1); PG_BAR; PG_SCHED;
            PG_LDB(B0, 1, 0); PG_LDB(B1, 1, 1); PG_SCHED; PG_LDA(At, 1, 0); PG_STAGE(PG_SA(0, 1), a2 + hA2, va2_0, va2_1);
            PG_WAIT_V(8); PG_WAIT_L(0); PG_BAR; PG_MMA(0, 0, At, B0); PG_MMA(0, 1, At, B1); PG_BAR; PG_SCHED;
            PG_LDA(At, 1, 1); PG_STAGE(PG_SB(1, 0), b3, vb2_0, vb2_1); PG_STAGE(PG_SB(1, 1), b3 + hB2, vb2_0, vb2_1); PG_STAGE(PG_SA(1, 0), a3, va2_0, va2_1);
            PG_WAIT_V(8); PG_WAIT_L(0); PG_BAR; PG_MMA(1, 0, At, B0); PG_MMA(1, 1, At, B1); PG_BAR; PG_SCHED;
        }
        if (wr == 0) PG_BAR;
        if constexpr (FP8) {
#pragma unroll
            for (int a = 0; a < 2; ++a)
#pragma unroll
                for (int b = 0; b < 2; ++b)
                    asm volatile("s_nop 15\n\ts_nop 15" : "+v"(acc[a][b][0][0]), "+v"(acc[a][b][0][1]), "+v"(acc[a][b][1][0]), "+v"(acc[a][b][1][1]),
                                 "+v"(acc[a][b][2][0]), "+v"(acc[a][b][2][1]), "+v"(acc[a][b][3][0]), "+v"(acc[a][b][3][1]) :: "memory"); }
        E(acc, cur, wr, wc, fr, fq);
        if (!has_next) break;
#pragma unroll
        for (int a = 0; a < 2; ++a)
#pragma unroll
            for (int b = 0; b < 2; ++b)
#pragma unroll
                for (int m = 0; m < 4; ++m)
#pragma unroll
                    for (int n = 0; n < 2; ++n) acc[a][b][m][n] = (f32x4){0.f, 0.f, 0.f, 0.f};
        cur = nxt; cA0 = nA0; cB0 = nB0; ++ui;
        if (TWO) { cA1 = g.A[1] + (long)cur.pm * g.tA[1] + (long)cur.grp * g.gA[1]; cB1 = g.B[1] + (long)cur.pn * g.tB[1] + (long)cur.grp * g.gB[1]; }
        if (wr == 1) PG_BAR;
    }
    PG_WAIT_V(0);
    PG_BAR;
}
}

#define EPI_LOOP_BEGIN \
    _Pragma("unroll") for (int ai = 0; ai < 2; ++ai) _Pragma("unroll") for (int m = 0; m < 4; ++m) { const int row = u.pm * 256 + ai * 128 + wr * 64 + m * 16 + fr; \
    _Pragma("unroll") for (int bj = 0; bj < 2; ++bj) {
#define EPI_LOOP_END } }
#define EPI_BATCH_BEGIN(ai0, ai1) \
    _Pragma("unroll") for (int ai = (ai0); ai < (ai1); ++ai) _Pragma("unroll") for (int m = 0; m < 4; ++m) { const int row = u.pm * 256 + ai * 128 + wr * 64 + m * 16 + fr; \
    _Pragma("unroll") for (int bj = 0; bj < 2; ++bj) { const int ck = ((ai - (ai0)) * 4 + m) * 2 + bj; (void)ck; (void)row;
#define EPI_BATCH_END } }

struct EpiG1 {
    static constexpr bool PERM = true; static constexpr bool MID = false;
    unsigned char* ws; const float* bgate;
    __device__ __forceinline__ void generic(const f32x4 (&acc)[2][2][4][2], const pg::Unit& u, int wr, int wc, int fr, int fq) const {
        const int pn = u.pn;
        bf16_t* const AG = (bf16_t*)(ws + WS_AG); bf16_t* const UMETA = (bf16_t*)(ws + WS_UMETA); bf16_t* const Q = (bf16_t*)(ws + WS_Q);
        bf16_t* const K = (bf16_t*)(ws + WS_K); bf16_t* const V = (bf16_t*)(ws + WS_V); bf16_t* const GATES = (bf16_t*)(ws + WS_GATES);
        EPI_LOOP_BEGIN
            const int c0 = pn * 256 + bj * 128 + wc * 32 + 8 * fq;
            f32x4 v0 = acc[ai][bj][m][0] * (1.0f / 512.0f), v1 = acc[ai][bj][m][1] * (1.0f / 512.0f);
            bf16_t* dst = nullptr;
            if (pn < 4) {
                if (row < TOK) { const int g = c0 >> 4, ch = c0 & 15; dst = AG + ((size_t)g * NCHUNK + (row >> 6)) * LDA_G + (row & 63) * 16 + ch; }
                else if (row < TOK + N_META) dst = UMETA + (size_t)(row - TOK) * 1024 + c0;
            } else if (pn < 8) {
                if (row < TOK) { dst = Q + (size_t)row * 1024 + (c0 - 1024); const float sc = 0.08838834764831845f * LOG2E; v0 = v0 * sc; v1 = v1 * sc; }
            } else if (pn == 8) { if (row < TOK + N_META) dst = K + (size_t)row * 256 + (c0 - 2048);
            } else if (pn == 9) { if (row < TOK + N_META) dst = V + (size_t)row * 256 + (c0 - 2304);
            } else {
                if (row < TOK) { const int cg_ = c0 - 2560;
                    const f32x4 b0 = *(const f32x4*)(bgate + cg_), b1 = *(const f32x4*)(bgate + cg_ + 4);
#pragma unroll
                    for (int j = 0; j < 4; ++j) { v0[j] = sigmoidf_(v0[j] + b0[j]); v1[j] = sigmoidf_(v1[j] + b1[j]); }
                    const size_t tile = (size_t)u.pm * 16 + (pn - 10); const int idx = (ai * 4 + m) * 2 + bj;
                    u32x4 w; w.x = cvt_pk_bf16(v0[0], v0[1]); w.y = cvt_pk_bf16(v0[2], v0[3]); w.z = cvt_pk_bf16(v1[0], v1[1]); w.w = cvt_pk_bf16(v1[2], v1[3]);
                    *(u32x4*)((unsigned char*)GATES + ((tile * 8 + (wr * 4 + wc)) * 16 + idx) * 1024 + (fr + 16 * fq) * 16) = w; }
            }
            if (dst) { u32x4 w; w.x = cvt_pk_bf16(v0[0], v0[1]); w.y = cvt_pk_bf16(v0[2], v0[3]); w.z = cvt_pk_bf16(v1[0], v1[1]); w.w = cvt_pk_bf16(v1[2], v1[3]); *(u32x4*)dst = w; }
        EPI_LOOP_END
    }
    __device__ __forceinline__ void operator()(const f32x4 (&acc)[2][2][4][2], const pg::Unit& u, int wr, int wc, int fr, int fq) const {
        const int pn = u.pn;
        if (u.pm >= TOK / 256) { generic(acc, u, wr, wc, fr, fq); return; }
#define EPI_PACK(w_, v0_, v1_) u32x4 w_; w_.x = cvt_pk_bf16(v0_[0], v0_[1]); w_.y = cvt_pk_bf16(v0_[2], v0_[3]); w_.z = cvt_pk_bf16(v1_[0], v1_[1]); w_.w = cvt_pk_bf16(v1_[2], v1_[3])
        if (pn >= 10) {
            bf16_t* const GATES = (bf16_t*)(ws + WS_GATES);
            f32x4 gb[2][2];
#pragma unroll
            for (int bj = 0; bj < 2; ++bj) { const int cg_ = pn * 256 - 2560 + bj * 128 + wc * 32 + 8 * fq; gb[bj][0] = *(const f32x4*)(bgate + cg_); gb[bj][1] = *(const f32x4*)(bgate + cg_ + 4); }
            const size_t tile = (size_t)u.pm * 16 + (pn - 10);
            EPI_LOOP_BEGIN
                f32x4 v0 = acc[ai][bj][m][0] * (1.0f / 512.0f), v1 = acc[ai][bj][m][1] * (1.0f / 512.0f);
#pragma unroll
                for (int j = 0; j < 4; ++j) { v0[j] = sigmoidf_(v0[j] + gb[bj][0][j]); v1[j] = sigmoidf_(v1[j] + gb[bj][1][j]); }
                const int idx = (ai * 4 + m) * 2 + bj; (void)row;
                EPI_PACK(w, v0, v1);
                *(u32x4*)((unsigned char*)GATES + ((tile * 8 + (wr * 4 + wc)) * 16 + idx) * 1024 + (fr + 16 * fq) * 16) = w;
            EPI_LOOP_END
        } else if (pn < 4) {
            bf16_t* const AG = (bf16_t*)(ws + WS_AG);
            EPI_LOOP_BEGIN
                const int c0 = pn * 256 + bj * 128 + wc * 32 + 8 * fq; const int g = c0 >> 4, ch = c0 & 15;
                const f32x4 v0 = acc[ai][bj][m][0] * (1.0f / 512.0f), v1 = acc[ai][bj][m][1] * (1.0f / 512.0f);
                EPI_PACK(w, v0, v1);
                *(u32x4*)(AG + ((size_t)g * NCHUNK + (row >> 6)) * LDA_G + (row & 63) * 16 + ch) = w;
            EPI_LOOP_END
        } else {
            bf16_t* const base = pn < 8 ? (bf16_t*)(ws + WS_Q) : pn == 8 ? (bf16_t*)(ws + WS_K) : (bf16_t*)(ws + WS_V);
            const int ld = pn < 8 ? 1024 : 256, coff = pn < 8 ? 1024 : pn == 8 ? 2048 : 2304;
            const float sc = (pn < 8 ? 0.08838834764831845f * LOG2E : 1.0f) * (1.0f / 512.0f);
            EPI_LOOP_BEGIN
                const int c0 = pn * 256 + bj * 128 + wc * 32 + 8 * fq;
                const f32x4 v0 = acc[ai][bj][m][0] * sc, v1 = acc[ai][bj][m][1] * sc;
                EPI_PACK(w, v0, v1);
                *(u32x4*)(base + (size_t)row * ld + (c0 - coff)) = w;
            EPI_LOOP_END
        }
#undef EPI_PACK
    }
};
struct EpiGates {
    static constexpr bool PERM = true;
    unsigned char* GATES; const float* bgate;
    __device__ __forceinline__ void operator()(const f32x4 (&acc)[2][2][4][2], const pg::Unit& u, int wr, int wc, int fr, int fq) const {
        asm volatile("" : "+v"(fr), "+v"(fq));
        EPI_LOOP_BEGIN
            (void)row; const int cg_ = u.pn * 256 + bj * 128 + wc * 32 + 8 * fq;
            f32x4 v0 = acc[ai][bj][m][0] * (1.0f / 512.0f), v1 = acc[ai][bj][m][1] * (1.0f / 512.0f);
            const f32x4 b0 = *(const f32x4*)(bgate + cg_), b1 = *(const f32x4*)(bgate + cg_ + 4);
#pragma unroll
            for (int j = 0; j < 4; ++j) { v0[j] = sigmoidf_(v0[j] + b0[j]); v1[j] = sigmoidf_(v1[j] + b1[j]); }
            const size_t tile = (size_t)u.pm * 16 + u.pn; const int idx = (ai * 4 + m) * 2 + bj;
            u32x4 w; w.x = cvt_pk_bf16(v0[0], v0[1]); w.y = cvt_pk_bf16(v0[2], v0[3]); w.z = cvt_pk_bf16(v1[0], v1[1]); w.w = cvt_pk_bf16(v1[2], v1[3]);
            *(u32x4*)(GATES + ((tile * 8 + (wr * 4 + wc)) * 16 + idx) * 1024 + (fr + 16 * fq) * 16) = w;
        EPI_LOOP_END
    }
};
struct EpiG2 {
    static constexpr bool PERM = false;
    float* S;
    __device__ __forceinline__ void operator()(const f32x4 (&acc)[2][2][4][2], const pg::Unit& u, int wr, int wc, int fr, int fq) const {
        EPI_LOOP_BEGIN
#pragma unroll
            for (int n = 0; n < 2; ++n) { const int c = bj * 128 + wc * 32 + 16 * n + 4 * fq; *(f32x4*)(S + ((size_t)u.grp * NCHUNK + row) * 256 + c) = acc[ai][bj][m][n]; }
        EPI_LOOP_END
    }
};
struct EpiG3 {
    static constexpr bool PERM = true;
    const bf16_t* AG; const float* dskip; bf16_t* YAPRE;
    __device__ __forceinline__ void operator()(const f32x4 (&acc)[2][2][4][2], const pg::Unit& u, int wr, int wc, int fr, int fq) const {
        const int g = u.grp;
        u32x4 uq[16];
        const int chq = (8 * fq) & 15;
        const f32x4 d0 = *(const f32x4*)(dskip + g * 16 + chq), d1 = *(const f32x4*)(dskip + g * 16 + chq + 4);
        EPI_BATCH_BEGIN(0, 2)
            const int c0 = u.pn * 256 + bj * 128 + wc * 32 + 8 * fq;
            uq[ck] = *(const u32x4*)(AG + ((size_t)g * NCHUNK + row) * LDA_G + c0);
        EPI_BATCH_END
        EPI_BATCH_BEGIN(0, 2)
            const int c0 = u.pn * 256 + bj * 128 + wc * 32 + 8 * fq;
            const int tp = c0 >> 4, ch = c0 & 15;
            const u32x4 uu = uq[ck];
            const f32x4 v0 = acc[ai][bj][m][0], v1 = acc[ai][bj][m][1];
            float y[8];
            y[0] = v0[0] + d0[0] * bf_lo(uu.x); y[1] = v0[1] + d0[1] * bf_hi(uu.x); y[2] = v0[2] + d0[2] * bf_lo(uu.y); y[3] = v0[3] + d0[3] * bf_hi(uu.y);
            y[4] = v1[0] + d1[0] * bf_lo(uu.z); y[5] = v1[1] + d1[1] * bf_hi(uu.z); y[6] = v1[2] + d1[2] * bf_lo(uu.w); y[7] = v1[3] + d1[3] * bf_hi(uu.w);
#pragma unroll
            for (int j = 0; j < 8; ++j) y[j] = gelu_tanh(y[j]);
            u32x4 w; w.x = cvt_pk_bf16(y[0], y[1]); w.y = cvt_pk_bf16(y[2], y[3]); w.z = cvt_pk_bf16(y[4], y[5]); w.w = cvt_pk_bf16(y[6], y[7]);
            *(u32x4*)(YAPRE + ((size_t)row * 64 + tp) * 1024 + g * 16 + ch) = w;
        EPI_BATCH_END
    }
};
template <int MODE> struct EpiBf {
    static constexpr bool PERM = true;
    bf16_t* O; int ldo; const bf16_t* aux; int ldaux; const bf16_t* gate; const float* bias; const float* rss;
    static constexpr float ascale = (MODE == 1 || MODE == 2) ? 1.0f / 256.0f : 1.0f;
    __device__ __forceinline__ void operator()(const f32x4 (&acc)[2][2][4][2], const pg::Unit& u, int wr, int wc, int fr, int fq) const {
        constexpr int NB = (MODE == 2) ? 2 : 1;
        const int wv = wr * 4 + wc, ln = fr + 16 * fq;
        f32x4 bia[2][2];
        if (MODE == 0) {
#pragma unroll
            for (int bj = 0; bj < 2; ++bj) { const int c0 = u.pn * 256 + bj * 128 + wc * 32 + 8 * fq; bia[bj][0] = *(const f32x4*)(bias + c0); bia[bj][1] = *(const f32x4*)(bias + c0 + 4); } }
#pragma unroll
        for (int bb = 0; bb < NB; ++bb) { const int ai0 = bb * (2 / NB), ai1 = ai0 + 2 / NB;
            u32x4 LA[16 / NB], LB[MODE == 2 ? 16 / NB : 1];
            if (MODE != 3) {
                EPI_BATCH_BEGIN(ai0, ai1)
                    const int c0 = u.pn * 256 + bj * 128 + wc * 32 + 8 * fq; (void)c0;
                    if (MODE == 0) LA[ck] = *(const u32x4*)(aux + (size_t)row * ldaux + c0);
                    else { const int idx = (ai * 4 + m) * 2 + bj; const size_t gtile = (size_t)u.pm * 16 + (MODE == 2 ? 8 : 0) + u.pn, mtile = (size_t)u.pm * 8 + u.pn;
                        LA[ck] = *(const u32x4*)((const unsigned char*)gate + ((gtile * 8 + wv) * 16 + idx) * 1024 + ln * 16);
                        if (MODE == 2) LB[ck] = *(const u32x4*)((const unsigned char*)aux + ((mtile * 8 + wv) * 16 + idx) * 1024 + ln * 16); }
                EPI_BATCH_END
            }
            EPI_BATCH_BEGIN(ai0, ai1)
                const int c0 = u.pn * 256 + bj * 128 + wc * 32 + 8 * fq;
                const f32x4 v0 = acc[ai][bj][m][0] * ascale, v1 = acc[ai][bj][m][1] * ascale;
                float y[8] = {v0[0], v0[1], v0[2], v0[3], v1[0], v1[1], v1[2], v1[3]};
                if (MODE == 0) {
                    const u32x4 a = LA[ck];
                    const f32x4 b0 = bia[bj][0], b1 = bia[bj][1];
                    const float yy[8] = {bf_lo(a.x), bf_hi(a.x), bf_lo(a.y), bf_hi(a.y), bf_lo(a.z), bf_hi(a.z), bf_lo(a.w), bf_hi(a.w)};
                    const float bb_[8] = {b0[0], b0[1], b0[2], b0[3], b1[0], b1[1], b1[2], b1[3]};
#pragma unroll
                    for (int j = 0; j < 8; ++j) y[j] = yy[j] * sigmoidf_(y[j] + bb_[j]);
                } else if (MODE == 1 || MODE == 2) {
                    const int idx = (ai * 4 + m) * 2 + bj;
                    const size_t mtile = (size_t)u.pm * 8 + u.pn;
                    const u32x4 gq = LA[ck];
                    const float gg[8] = {bf_lo(gq.x), bf_hi(gq.x), bf_lo(gq.y), bf_hi(gq.y), bf_lo(gq.z), bf_hi(gq.z), bf_lo(gq.w), bf_hi(gq.w)};
                    if (MODE == 1) {
                        u32x4* mp = (u32x4*)((unsigned char*)O + ((mtile * 8 + wv) * 16 + idx) * 1024 + ln * 16);
#pragma unroll
                        for (int j = 0; j < 8; ++j) y[j] = (DBG & 4) ? 0.f : gg[j] * y[j];
                        u32x4 w; w.x = cvt_pk_bf16(y[0], y[1]); w.y = cvt_pk_bf16(y[2], y[3]); w.z = cvt_pk_bf16(y[4], y[5]); w.w = cvt_pk_bf16(y[6], y[7]);
                        *mp = w; continue;
                    } else {
                        const u32x4 a = LB[ck];
                        const float aa[8] = {bf_lo(a.x), bf_hi(a.x), bf_lo(a.y), bf_hi(a.y), bf_lo(a.z), bf_hi(a.z), bf_lo(a.w), bf_hi(a.w)};
                        float z[8];
#pragma unroll
                        for (int j = 0; j < 8; ++j) z[j] = 16.f * ((DBG & 8) ? aa[j] : aa[j] + gg[j] * y[j]);
                        int p0 = __builtin_amdgcn_cvt_pk_fp8_f32(z[0], z[1], 0, false); p0 = __builtin_amdgcn_cvt_pk_fp8_f32(z[2], z[3], p0, true);
                        int p1 = __builtin_amdgcn_cvt_pk_fp8_f32(z[4], z[5], 0, false); p1 = __builtin_amdgcn_cvt_pk_fp8_f32(z[6], z[7], p1, true);
                        *(u32x2*)((unsigned char*)O + (size_t)row * ldo + c0) = (u32x2){(unsigned)p0, (unsigned)p1}; continue;
                    }
                }
                if (MODE == 0) {
                    int p0 = __builtin_amdgcn_cvt_pk_fp8_f32(y[0], y[1], 0, false); p0 = __builtin_amdgcn_cvt_pk_fp8_f32(y[2], y[3], p0, true);
                    int p1 = __builtin_amdgcn_cvt_pk_fp8_f32(y[4], y[5], 0, false); p1 = __builtin_amdgcn_cvt_pk_fp8_f32(y[6], y[7], p1, true);
                    *(u32x2*)((unsigned char*)O + (size_t)row * ldo + c0) = (u32x2){(unsigned)p0, (unsigned)p1}; continue; }
                u32x4 w; w.x = cvt_pk_bf16(y[0], y[1]); w.y = cvt_pk_bf16(y[2], y[3]); w.z = cvt_pk_bf16(y[4], y[5]); w.w = cvt_pk_bf16(y[6], y[7]);
                *(u32x4*)(O + (size_t)row * ldo + c0) = w;
            EPI_BATCH_END
        }
    }
};
struct EpiG6 {
    static constexpr bool PERM = false;
    const float* x; bf16_t* HS1B; float* rss;
    __device__ __forceinline__ void operator()(const f32x4 (&acc)[2][2][4][2], const pg::Unit& u, int wr, int wc, int fr, int fq) const {
#pragma unroll
        for (int ai = 0; ai < 2; ++ai) {
            f32x4 xq[4][2][2];
#pragma unroll
            for (int m = 0; m < 4; ++m) { const int row = u.pm * 256 + ai * 128 + wr * 64 + m * 16 + fr;
#pragma unroll
                for (int bj = 0; bj < 2; ++bj)
#pragma unroll
                    for (int n = 0; n < 2; ++n) { const int c = u.pn * 256 + bj * 128 + wc * 32 + 16 * n + 4 * fq; xq[m][bj][n] = *(const f32x4*)(x + (size_t)row * 2048 + c); } }
#pragma unroll
            for (int m = 0; m < 4; ++m) { const int row = u.pm * 256 + ai * 128 + wr * 64 + m * 16 + fr; float ss = 0.f;
#pragma unroll
                for (int bj = 0; bj < 2; ++bj)
#pragma unroll
                    for (int n = 0; n < 2; ++n) { const int c = u.pn * 256 + bj * 128 + wc * 32 + 16 * n + 4 * fq; const size_t off = (size_t)row * 2048 + c;
                        const f32x4 h = (DBG & 1) ? xq[m][bj][n] : xq[m][bj][n] + acc[ai][bj][m][n] * (1.0f / 8192.0f);
                        ss += (h[0] * h[0] + h[1] * h[1]) + (h[2] * h[2] + h[3] * h[3]);
                        u32x2 w; w.x = cvt_pk_bf16(h[0], h[1]); w.y = cvt_pk_bf16(h[2], h[3]); *(u32x2*)(HS1B + off) = w; }
                ss += __shfl_xor(ss, 16); ss += __shfl_xor(ss, 32);
                if (fq == 0) rss[(size_t)row * 32 + u.pn * 4 + wc] = ss; } }
    }
};

struct Args {
    const float* x; const float* meta; const float* norm_mix; const float* w_in; const float* b_gate;
    const float* lam_re; const float* lam_im; const float* log_dt; const float* b_re; const float* b_im; const float* c_re; const float* c_im;
    const float* ssm_d; const float* w_glu; const float* b_glu; const float* sink; const float* w_ps; const float* w_pa; const float* w_out;
    const float* norm_ffn; const float* w_q; const float* pk1; const float* pk2; const float* pu; const float* pv; const float* norm_final;
    float* out; unsigned char* ws; int ph_lo, ph_hi;
};

__device__ __forceinline__ void p0_transpose_item(const float* W, int K, int N, bf16_t* WT, LAS float* scr, int item, int lane, const float* rowgain = nullptr, unsigned char* WT8 = nullptr, int n8_0 = 0, float s8 = 512.f) {
    const int nblk = N / 32, kb = item / nblk, nb = item % nblk, k0 = 64 * kb, n0 = 32 * nb;
    { f32x4 t[8]; float gs[8];
#pragma unroll
      for (int g = 0; g < 8; ++g) { const int kk = 8 * g + (lane >> 3); t[g] = *(const f32x4*)(W + (size_t)(k0 + kk) * N + n0 + 4 * (lane & 7)); gs[g] = rowgain ? rowgain[k0 + kk] : 1.0f; }
#pragma unroll
      for (int g = 0; g < 8; ++g) { const int kk = 8 * g + (lane >> 3); LAS float* d = scr + kk * 33 + 4 * (lane & 7);
          d[0] = gs[g] * t[g][0]; d[1] = gs[g] * t[g][1]; d[2] = gs[g] * t[g][2]; d[3] = gs[g] * t[g][3]; } }
    LDS_WAIT(); asm volatile("" ::: "memory");
    const int c = lane & 7;
#pragma unroll
    for (int j = 0; j < 4; ++j) { const int n = (lane >> 3) + 8 * j; const LAS float* s = scr + (8 * c) * 33 + n;
        u32x4 o; o.x = cvt_pk_bf16(s[0 * 33], s[1 * 33]); o.y = cvt_pk_bf16(s[2 * 33], s[3 * 33]); o.z = cvt_pk_bf16(s[4 * 33], s[5 * 33]); o.w = cvt_pk_bf16(s[6 * 33], s[7 * 33]);
        if (WT) *(u32x4*)(WT + (size_t)(n0 + n) * K + k0 + 8 * c) = o;
        if (WT8 && n0 >= n8_0) { int p0 = __builtin_amdgcn_cvt_pk_fp8_f32(s8 * s[0 * 33], s8 * s[1 * 33], 0, false); p0 = __builtin_amdgcn_cvt_pk_fp8_f32(s8 * s[2 * 33], s8 * s[3 * 33], p0, true);
            int p1 = __builtin_amdgcn_cvt_pk_fp8_f32(s8 * s[4 * 33], s8 * s[5 * 33], 0, false); p1 = __builtin_amdgcn_cvt_pk_fp8_f32(s8 * s[6 * 33], s8 * s[7 * 33], p1, true);
            *(u32x2*)(WT8 + (size_t)(n0 + n - n8_0) * K + k0 + 8 * c) = (u32x2){(unsigned)p0, (unsigned)p1}; } }
    LDS_WAIT(); asm volatile("" ::: "memory");
}
__device__ __forceinline__ void rowA_load(const float* src, int lane, f32x4 (&v)[8]) {
#pragma unroll
    for (int i = 0; i < 4; ++i) { const f32x4* p = (const f32x4*)(src + (i * 64 + lane) * 8); v[2 * i] = p[0]; v[2 * i + 1] = p[1]; }
}
__device__ __forceinline__ void rowA_finish(const f32x4 (&v)[8], bf16_t* dst, int lane, bool norm, const float* gain, unsigned char* dst8, const f32x4* gpre = nullptr) {
    float rs = 1.0f;
    if (norm) { float s = 0.f;
#pragma unroll
        for (int i = 0; i < 8; ++i) s += (v[i][0] * v[i][0] + v[i][1] * v[i][1]) + (v[i][2] * v[i][2] + v[i][3] * v[i][3]);
        rs = 1.0f / sqrtf(wave_sum(s) * (1.0f / 2048.0f) + NORM_EPS); }
#pragma unroll
    for (int i = 0; i < 4; ++i) { f32x4 a = v[2 * i] * rs, b = v[2 * i + 1] * rs;
        if (norm) { if (gpre) { a = a * gpre[2 * i]; b = b * gpre[2 * i + 1]; }
                    else { const f32x4* gp = (const f32x4*)(gain + (i * 64 + lane) * 8); a = a * gp[0]; b = b * gp[1]; } }
        u32x4 w; w.x = cvt_pk_bf16(a[0], a[1]); w.y = cvt_pk_bf16(a[2], a[3]); w.z = cvt_pk_bf16(b[0], b[1]); w.w = cvt_pk_bf16(b[2], b[3]);
        if (dst) *(u32x4*)(dst + (i * 64 + lane) * 8) = w;
        if (dst8) { int p0 = __builtin_amdgcn_cvt_pk_fp8_f32(a[0], a[1], 0, false); p0 = __builtin_amdgcn_cvt_pk_fp8_f32(a[2], a[3], p0, true);
            int p1 = __builtin_amdgcn_cvt_pk_fp8_f32(b[0], b[1], 0, false); p1 = __builtin_amdgcn_cvt_pk_fp8_f32(b[2], b[3], p1, true);
            *(u32x2*)(dst8 + (i * 64 + lane) * 8) = (u32x2){(unsigned)p0, (unsigned)p1}; } }
}
__device__ __forceinline__ void row_to_bf16(const float* src, bf16_t* dst, int lane, bool norm, const float* gain, unsigned char* dst8 = nullptr) {
    f32x4 v[8]; rowA_load(src, lane, v); rowA_finish(v, dst, lane, norm, gain, dst8);
}
__device__ __forceinline__ void row_to_fp8(const float* src, unsigned char* dst, float* inv, int lane, const float* gain) {
    f32x4 v[8]; float am = 0.f;
#pragma unroll
    for (int i = 0; i < 2; ++i)
#pragma unroll
        for (int j = 0; j < 4; ++j) { v[4 * i + j] = *(const f32x4*)(src + (i * 64 + lane) * 16 + 4 * j) * *(const f32x4*)(gain + (i * 64 + lane) * 16 + 4 * j);
            am = fmaxf(am, fmaxf(fmaxf(fabsf(v[4 * i + j][0]), fabsf(v[4 * i + j][1])), fmaxf(fabsf(v[4 * i + j][2]), fabsf(v[4 * i + j][3])))); }
#pragma unroll
    for (int o = 1; o < 64; o <<= 1) am = fmaxf(am, __shfl_xor(am, o));
    float sc = 1.0f, isc = 1.0f;
    if (am > 0.f) { const float e = floorf(log2f(224.0f / am)); sc = exp2f(e); isc = exp2f(-e); }
    if (lane == 0) *inv = isc;
#pragma unroll
    for (int i = 0; i < 2; ++i) { u32x4 w;
#pragma unroll
        for (int j = 0; j < 4; ++j) { const f32x4 x = v[4 * i + j] * sc; int pk = __builtin_amdgcn_cvt_pk_fp8_f32(x[0], x[1], 0, false); pk = __builtin_amdgcn_cvt_pk_fp8_f32(x[2], x[3], pk, true); w[j] = (unsigned)pk; }
        *(u32x4*)(dst + (i * 64 + lane) * 16) = w; }
}
#ifndef FMT6
#define FMT6 1
#endif
#ifndef HWPK4
#define HWPK4 1
#endif
#define SC4_BIAS 840
#ifndef TIME_DOTS
#define TIME_DOTS 0
#endif
#ifndef DOTS_PROBE
#define DOTS_PROBE 0
#endif
#ifndef MFMA_A
#define MFMA_A 1
#endif
#ifndef UFMT4
#define UFMT4 1
#endif
__device__ __forceinline__ void rowB_load(const float* src, int lane, f32x4 (&v)[8]) {
#pragma unroll
    for (int j = 0; j < 8; ++j) v[j] = *(const f32x4*)(src + (j * 64 + lane) * 4);
}
__device__ __forceinline__ void fp6_finish(const f32x4 (&vin)[8], unsigned char* dst, float* inv, int lane, const float* gain) {
    f32x16 va, vb; float am = 0.f;
#pragma unroll
    for (int j = 0; j < 8; ++j) { f32x4 v = vin[j]; if (gain) v = v * *(const f32x4*)(gain + (j * 64 + lane) * 4);
        am = fmaxf(am, fmaxf(fmaxf(fabsf(v[0]), fabsf(v[1])), fmaxf(fabsf(v[2]), fabsf(v[3]))));
        va[2 * j] = v[0]; vb[2 * j] = v[1]; va[2 * j + 1] = v[2]; vb[2 * j + 1] = v[3]; }
#pragma unroll
    for (int o = 1; o < 64; o <<= 1) am = fmaxf(am, __shfl_xor(am, o));
    float sc = 1.0f, isc = 1.0f;
    if (am > 0.f) { const float e = floorf(log2f(7.5f / am)); sc = exp2f(e); isc = exp2f(-e); }
    if (lane == 0) *inv = isc;
    va = va * sc; vb = vb * sc;
    const u32x6 r = __builtin_amdgcn_cvt_scalef32_2xpk16_fp6_f32(va, vb, 1.0f);
    *(u32x4*)(dst + 16 * lane) = (u32x4){r[0], r[1], r[2], r[3]};
    *(u32x2*)(dst + 1024 + 8 * lane) = (u32x2){r[4], r[5]};
}
__device__ __forceinline__ void row_to_fp6(const float* src, unsigned char* dst, float* inv, int lane, const float* gain = nullptr) {
    f32x4 v[8]; rowB_load(src, lane, v); fp6_finish(v, dst, inv, lane, gain);
}
template <bool E8 = false>
__device__ __forceinline__ void fp4_finish(const f32x4 (&vin)[8], unsigned char* dst, unsigned char* scl, int lane, const float* gain = nullptr, const f32x4* gpre = nullptr) {
    f32x4 v[8]; float am = 0.f;
#pragma unroll
    for (int j = 0; j < 8; ++j) { v[j] = vin[j]; if (gpre) v[j] = v[j] * gpre[j]; else if (gain) v[j] = v[j] * *(const f32x4*)(gain + (j * 64 + lane) * 4); }
#pragma unroll
    for (int j = 0; j < 8; ++j) am = fmaxf(am, fmaxf(fmaxf(fabsf(v[j][0]), fabsf(v[j][1])), fmaxf(fabsf(v[j][2]), fabsf(v[j][3]))));
    float sc;
    if constexpr (E8) {
        sc = 1.0f; int eb = 127; if (am > 0.f) { const float e = fminf(floorf(log2f(6.0f / am)), 126.f); sc = exp2f(e); eb = 127 - (int)e; }
        scl[(lane & 3) * 16 + (lane >> 2)] = (unsigned char)eb;
    } else {
        int cb = (int)((__float_as_uint(am * (1.0f / 6.0f)) + (1u << 19)) >> 20) - SC4_BIAS; cb = cb < 0 ? 0 : (cb > 255 ? 255 : cb);
        sc = 1.0f / __uint_as_float((unsigned)(cb + SC4_BIAS) << 20);
        scl[lane] = (unsigned char)cb; }
    u32x4 w = {0u, 0u, 0u, 0u};
#if HWPK4
#pragma unroll
    for (int d = 0; d < 4; ++d) { unsigned x = 0u;
        x = __builtin_amdgcn_cvt_scalef32_pk_fp4_f32(x, v[2 * d][0] * sc, v[2 * d][1] * sc, 1.0f, 0);
        x = __builtin_amdgcn_cvt_scalef32_pk_fp4_f32(x, v[2 * d][2] * sc, v[2 * d][3] * sc, 1.0f, 1);
        x = __builtin_amdgcn_cvt_scalef32_pk_fp4_f32(x, v[2 * d + 1][0] * sc, v[2 * d + 1][1] * sc, 1.0f, 2);
        x = __builtin_amdgcn_cvt_scalef32_pk_fp4_f32(x, v[2 * d + 1][2] * sc, v[2 * d + 1][3] * sc, 1.0f, 3);
        w[d] = x; }
#else
#pragma unroll
    for (int j = 0; j < 8; ++j)
#pragma unroll
        for (int q = 0; q < 4; ++q) { const float y = v[j][q] * sc, a = fabsf(y);
            const unsigned code = (unsigned)(a > 0.25f) + (unsigned)(a > 0.75f) + (unsigned)(a > 1.25f) + (unsigned)(a > 1.75f) + (unsigned)(a > 2.5f) + (unsigned)(a > 3.5f) + (unsigned)(a > 5.0f) + ((__float_as_uint(y) >> 31) << 3);
            const int i = 4 * j + q; w[i >> 3] |= code << (4 * (i & 7)); }
#endif
    *(u32x4*)(dst + 16 * lane) = w;
}
template <bool E8 = false>
__device__ __forceinline__ void row_to_fp4(const float* src, unsigned char* dst, unsigned char* scl, int lane, const float* gain = nullptr) {
    f32x4 v[8]; rowB_load(src, lane, v); fp4_finish<E8>(v, dst, scl, lane, gain);
}
__device__ __forceinline__ void p0_s5_tables(const Args& a, LAS unsigned char* lds, int g) {
    LAS float* apw = (LAS float*)lds;
    LAS float* Bb = apw + 2 * 65 * 64 * 2;
    LAS float* Cc = Bb + 2 * 64 * 16 * 2;
    const int tid = tid_fresh();
    unsigned char* ws = a.ws;
    float* S5M = (float*)(ws + WS_S5M);
    float* A64 = S5M; float* AP16 = S5M + 2 * 64 * 64 * 2; float* BB0 = AP16 + 64 * 64 * 16 * 2;
    if (tid < 128) {
        const int r = tid >> 6, p = tid & 63; const int gi = r * 64 + g;
        const double dt = exp((double)a.log_dt[gi]); const double lr = (double)a.lam_re[gi * 64 + p], li = (double)a.lam_im[gi * 64 + p];
        double a1r = 0, a1i = 0;
        const double m1 = exp(lr * dt), b1r = m1 * cos(li * dt), b1i = m1 * sin(li * dt);
        double cr = 1.0, ci = 0.0;
        for (int n = 0; n <= 64; ++n) { if (n > 0) { const double tr = cr * b1r - ci * b1i, ti = cr * b1i + ci * b1r; cr = tr; ci = ti; }
            apw[((r * 65 + n) * 64 + p) * 2] = (float)cr; apw[((r * 65 + n) * 64 + p) * 2 + 1] = (float)ci; if (n == 1) { a1r = cr; a1i = ci; }
            if (n == 64) { A64[(gi * 64 + p) * 2] = (float)cr; A64[(gi * 64 + p) * 2 + 1] = (float)ci; }
            if (r == 0 && n < 16) { AP16[((g * 64 + p) * 16 + n) * 2] = (float)cr; AP16[((g * 64 + p) * 16 + n) * 2 + 1] = (float)ci; } }
        const double den = lr * lr + li * li, nr = a1r - 1.0, ni = a1i;
        const double cre = (nr * lr + ni * li) / den, cim = (ni * lr - nr * li) / den;
        for (int c = 0; c < 16; ++c) { const double br = (double)a.b_re[(gi * 64 + p) * 16 + c], bi = (double)a.b_im[(gi * 64 + p) * 16 + c];
            const float zr = (float)(cre * br - cim * bi), zi = (float)(cre * bi + cim * br);
            Bb[((r * 64 + p) * 16 + c) * 2] = zr; Bb[((r * 64 + p) * 16 + c) * 2 + 1] = zi;
            if (r == 0) { BB0[((g * 64 + p) * 16 + c) * 2] = zr; BB0[((g * 64 + p) * 16 + c) * 2 + 1] = zi; } }
    }
    for (int idx = tid; idx < 2048; idx += NTHREADS) { const int r = idx >> 10, c = (idx >> 6) & 15, p = idx & 63; const int gi = r * 64 + g;
        Cc[idx * 2] = a.c_re[(gi * 16 + c) * 64 + p]; Cc[idx * 2 + 1] = a.c_im[(gi * 16 + c) * 64 + p]; }
    __syncthreads();
    bf16_t* KT = (bf16_t*)(ws + WS_KTAB) + (size_t)g * 128 * 256;
    for (int idx = tid; idx < 127 * 16; idx += NTHREADS) { const int dd = idx >> 4, c = idx & 15, d = dd - 63;
        float acc[16];
#pragma unroll
        for (int j = 0; j < 16; ++j) acc[j] = 0.f;
#pragma unroll
        for (int r = 0; r < 2; ++r) { if ((r == 0 && d < 0) || (r == 1 && d > 0)) continue; const int n = d < 0 ? -d : d;
            for (int p = 0; p < 64; ++p) { const float cr = Cc[((r * 16 + c) * 64 + p) * 2], ci = Cc[((r * 16 + c) * 64 + p) * 2 + 1];
                const float ar = apw[((r * 65 + n) * 64 + p) * 2], ai = apw[((r * 65 + n) * 64 + p) * 2 + 1];
                const float zr = cr * ar - ci * ai, zi = cr * ai + ci * ar; const LAS float* bp = Bb + ((r * 64 + p) * 16) * 2;
#pragma unroll
                for (int j = 0; j < 16; ++j) acc[j] += zr * bp[2 * j] - zi * bp[2 * j + 1]; } }
        u32x4 w0, w1; w0.x = cvt_pk_bf16(acc[0], acc[1]); w0.y = cvt_pk_bf16(acc[2], acc[3]); w0.z = cvt_pk_bf16(acc[4], acc[5]); w0.w = cvt_pk_bf16(acc[6], acc[7]);
        w1.x = cvt_pk_bf16(acc[8], acc[9]); w1.y = cvt_pk_bf16(acc[10], acc[11]); w1.z = cvt_pk_bf16(acc[12], acc[13]); w1.w = cvt_pk_bf16(acc[14], acc[15]);
        u32x4* o = (u32x4*)(KT + (size_t)dd * 256 + c * 16); o[0] = w0; o[1] = w1; }
    bf16_t* PT = (bf16_t*)(ws + WS_PT) + (size_t)g * 256 * 1024;
    for (int idx = tid; idx < 256 * 64; idx += NTHREADS) { const int n = idx >> 6, s = idx & 63; const int r = n >> 7, ri = (n >> 6) & 1, p = n & 63; const int e = r == 0 ? 63 - s : s;
        const float ar = apw[((r * 65 + e) * 64 + p) * 2], ai = apw[((r * 65 + e) * 64 + p) * 2 + 1]; const LAS float* bp = Bb + ((r * 64 + p) * 16) * 2; float v[16];
#pragma unroll
        for (int j = 0; j < 16; ++j) v[j] = ri ? (ar * bp[2 * j + 1] + ai * bp[2 * j]) : (ar * bp[2 * j] - ai * bp[2 * j + 1]);
        u32x4 w0, w1; w0.x = cvt_pk_bf16(v[0], v[1]); w0.y = cvt_pk_bf16(v[2], v[3]); w0.z = cvt_pk_bf16(v[4], v[5]); w0.w = cvt_pk_bf16(v[6], v[7]);
        w1.x = cvt_pk_bf16(v[8], v[9]); w1.y = cvt_pk_bf16(v[10], v[11]); w1.z = cvt_pk_bf16(v[12], v[13]); w1.w = cvt_pk_bf16(v[14], v[15]);
        u32x4* o = (u32x4*)(PT + (size_t)n * 1024 + s * 16); o[0] = w0; o[1] = w1; }
    bf16_t* QT = (bf16_t*)(ws + WS_QT) + (size_t)g * 1024 * 256;
    for (int idx = tid; idx < 1024 * 32; idx += NTHREADS) { const int n = idx >> 5, k0 = (idx & 31) * 8; const int t = n >> 4, c = n & 15; const int r = k0 >> 7, ri = (k0 >> 6) & 1, p0 = k0 & 63;
        const int e = r == 0 ? t + 1 : 64 - t; float v[8];
#pragma unroll
        for (int j = 0; j < 8; ++j) { const int p = p0 + j; const float cr = Cc[((r * 16 + c) * 64 + p) * 2], ci = Cc[((r * 16 + c) * 64 + p) * 2 + 1];
            const float ar = apw[((r * 65 + e) * 64 + p) * 2], ai = apw[((r * 65 + e) * 64 + p) * 2 + 1]; v[j] = ri ? -(cr * ai + ci * ar) : (cr * ar - ci * ai); }
        u32x4 w; w.x = cvt_pk_bf16(v[0], v[1]); w.y = cvt_pk_bf16(v[2], v[3]); w.z = cvt_pk_bf16(v[4], v[5]); w.w = cvt_pk_bf16(v[6], v[7]);
        *(u32x4*)(QT + (size_t)n * 256 + k0) = w; }
    __syncthreads();
}

__device__ __forceinline__ void phase0(const Args& a, LAS unsigned char* lds) {
    const int tid = tid_fresh(), lane = tid & 63, wave = tid >> 6, G = gridDim.x;
    unsigned char* ws = a.ws;
    for (int g = blockIdx.x; g < 64; g += G) p0_s5_tables(a, lds, g);
    __syncthreads();
    const int gw = blockIdx.x * NWAVES + wave, NGW = G * NWAVES;
    LAS float* scr = (LAS float*)(lds + wave * 16384);
    constexpr int I_IN = 32 * 208, I_GLU = 16 * 32, I_PS = 16 * 64, I_OUT = 32 * 64;
    constexpr int NT_ITEMS = I_IN + I_GLU + 2 * I_PS + 2 * I_OUT;
    const bool tsplit = (G >= 128); const int gwT = tsplit ? (blockIdx.x - 64) * NWAVES + wave : gw, NGWT = tsplit ? (G - 64) * NWAVES : NGW;
    if (!tsplit || blockIdx.x >= 64)
    for (int it = gwT; it < NT_ITEMS; it += NGWT) {
        int r = it;
        if (r < I_IN) { p0_transpose_item(a.w_in, 2048, IN_COLS, nullptr, scr, r, lane, nullptr, ws + WS_WG8, 0); continue; } r -= I_IN;
        if (r < I_GLU) { p0_transpose_item(a.w_glu, 1024, 1024, (bf16_t*)(ws + WS_WGLU), scr, r, lane); continue; } r -= I_GLU;
        if (r < I_PS) { p0_transpose_item(a.w_ps, 1024, 2048, nullptr, scr, r, lane, nullptr, ws + WS_WP8, 0, 256.f); continue; } r -= I_PS;
        if (r < I_PS) { p0_transpose_item(a.w_pa, 1024, 2048, nullptr, scr, r, lane, nullptr, ws + WS_WP8 + 2048 * 1024, 0, 256.f); continue; } r -= I_PS;
        if (r < I_OUT) { p0_transpose_item(a.w_out, 2048, 2048, nullptr, scr, r, lane, nullptr, ws + WS_WOUT, 0, 512.f); continue; } r -= I_OUT;
        p0_transpose_item(a.w_q, 2048, 2048, (bf16_t*)(ws + WS_WQ), scr, r, lane, a.norm_ffn);
    }
    constexpr int R_NORM = MROWS, R_U = 16384, R_PK = 128;
    unsigned* rctr = (unsigned*)(ws + 32768 + 256);
    constexpr int R_TOTAL = R_NORM + 2 * R_U + R_PK;
    f32x4 gmix[8];
#pragma unroll
    for (int i = 0; i < 4; ++i) { const f32x4* gp = (const f32x4*)(a.norm_mix + (i * 64 + lane) * 8); gmix[2 * i] = gp[0]; gmix[2 * i + 1] = gp[1]; }
    for (;;) {
        unsigned base = 0u; if (lane == 0) base = __hip_atomic_fetch_add(rctr, 8u, __ATOMIC_RELAXED, __HIP_MEMORY_SCOPE_AGENT);
        base = (unsigned)__builtin_amdgcn_readfirstlane((int)base);
        if (base >= (unsigned)R_TOTAL) break;
      if ((int)base < TOK) {
#pragma unroll 1
          for (int h4 = 0; h4 < 2; ++h4) { f32x4 v[4][8]; const int r0 = (int)base + 4 * h4;
#pragma unroll
              for (int q = 0; q < 4; ++q) rowA_load(a.x + (size_t)(r0 + q) * 2048, lane, v[q]);
#pragma unroll
              for (int q = 0; q < 4; ++q) rowA_finish(v[q], nullptr, lane, true, a.norm_mix, ws + WS_HA8 + (size_t)(r0 + q) * 2048, gmix); }
          continue; }
      if ((int)base >= R_NORM && (int)base < R_NORM + 2 * R_U) {
          const bool isu = (int)base < R_NORM + R_U; const int rb = (int)base - R_NORM - (isu ? 0 : R_U);
#pragma unroll 1
          for (int h4 = 0; h4 < 2; ++h4) { f32x4 v[4][8]; const int r0 = rb + 4 * h4;
#pragma unroll
              for (int q = 0; q < 4; ++q) rowB_load((isu ? a.pu : a.pv) + (size_t)(r0 + q) * 2048, lane, v[q]);
              if (isu) {
#pragma unroll
                  for (int q = 0; q < 4; ++q) {
                      if (UFMT4) fp4_finish<MFMA_A != 0>(v[q], ws + WS_UT + (size_t)(r0 + q) * 1024, ws + WS_ISU + (size_t)(r0 + q) * 64, lane, a.norm_ffn);
                      else fp6_finish(v[q], ws + WS_UT + (size_t)(r0 + q) * 1536, (float*)(ws + WS_ISU) + r0 + q, lane, a.norm_ffn); }
              } else {
#pragma unroll
                  for (int q = 0; q < 4; ++q) fp4_finish(v[q], ws + WS_VT + (size_t)(r0 + q) * 1024, ws + WS_ISV + (size_t)(r0 + q) * 64, lane); } }
          continue; }
      for (int it = (int)base; it < (int)base + 8 && it < R_TOTAL; ++it) {
        int r = it;
        if (r < R_NORM) {
            unsigned char* dst8 = ws + WS_HA8 + (size_t)r * 2048;
            if (r < TOK) row_to_bf16(a.x + (size_t)r * 2048, nullptr, lane, true, a.norm_mix, dst8);
            else if (r < TOK + N_META) row_to_bf16(a.meta + (size_t)(r - TOK) * 2048, nullptr, lane, true, a.norm_mix, dst8);
            else { const u32x4 z = {0u, 0u, 0u, 0u};
#pragma unroll
                for (int i = 0; i < 2; ++i) *(u32x4*)(dst8 + (i * 64 + lane) * 16) = z; }
            continue; }
        r -= R_NORM;
        if (r < R_U) { if (UFMT4) row_to_fp4<MFMA_A != 0>(a.pu + (size_t)r * 2048, ws + WS_UT + (size_t)r * 1024, ws + WS_ISU + (size_t)r * 64, lane, a.norm_ffn);
                       else row_to_fp6(a.pu + (size_t)r * 2048, ws + WS_UT + (size_t)r * 1536, (float*)(ws + WS_ISU) + r, lane, a.norm_ffn); continue; } r -= R_U;
        if (r < R_U) { row_to_fp4(a.pv + (size_t)r * 2048, ws + WS_VT + (size_t)r * 1024, ws + WS_ISV + (size_t)r * 64, lane); continue; } r -= R_U;
        if (r < 64) row_to_bf16(a.pk1 + (size_t)r * 2048, (bf16_t*)(ws + WS_PK) + (size_t)r * 2048, lane, false, nullptr);
        else row_to_bf16(a.pk2 + (size_t)(r - 64) * 2048, (bf16_t*)(ws + WS_PK) + 131072 + (size_t)(r - 64) * 2048, lane, false, nullptr);
      }
    }
}

__device__ __forceinline__ void scan_unit(const Args& a, int g, int pm) {
    unsigned char* ws = a.ws; const int tid = tid_fresh();
    const float* S5M = (const float*)(ws + WS_S5M);
    const float* A64 = S5M; const float* AP16 = S5M + 2 * 64 * 64 * 2; const float* BB0 = AP16 + 64 * 64 * 16 * 2;
    const bf16_t* UM = (const bf16_t*)(ws + WS_UMETA);
    if (tid < 256) {
        const int b = 2 * pm + (tid >> 7), r = (tid >> 6) & 1, p = tid & 63;
        const float ar = A64[((r * 64 + g) * 64 + p) * 2], ai = A64[((r * 64 + g) * 64 + p) * 2 + 1];
        const float* S = (const float*)(ws + WS_S) + ((size_t)g * NCHUNK + b * 128) * 256 + r * 128 + p;
        bf16_t* H = (bf16_t*)(ws + WS_AG) + ((size_t)g * NCHUNK + b * 128) * LDA_G + 1024 + r * 128 + p;
        float hr = 0.f, hi = 0.f;
        if (r == 0) {
            for (int m = 0; m < 16; ++m) { const float pr = AP16[((g * 64 + p) * 16 + (15 - m)) * 2], pi = AP16[((g * 64 + p) * 16 + (15 - m)) * 2 + 1];
                float br = 0.f, bi = 0.f;
                for (int c = 0; c < 16; ++c) { const float uv = bf_lo((unsigned)UM[m * 1024 + g * 16 + c]); br += BB0[((g * 64 + p) * 16 + c) * 2] * uv; bi += BB0[((g * 64 + p) * 16 + c) * 2 + 1] * uv; }
                hr += pr * br - pi * bi; hi += pr * bi + pi * br; }
        }
        for (int cb = 0; cb < 128; cb += 16) {
            float sr[16], si[16];
#pragma unroll
            for (int j = 0; j < 16; ++j) { const int c = (r == 0) ? cb + j : 127 - cb - j; sr[j] = S[(size_t)c * 256]; si[j] = S[(size_t)c * 256 + 64]; }
#pragma unroll
            for (int j = 0; j < 16; ++j) { const int c = (r == 0) ? cb + j : 127 - cb - j;
                H[(size_t)c * LDA_G] = (bf16_t)(cvt_pk_bf16(hr, hr) & 0xffffu); H[(size_t)c * LDA_G + 64] = (bf16_t)(cvt_pk_bf16(hi, hi) & 0xffffu);
                const float nr = ar * hr - ai * hi + sr[j], ni = ar * hi + ai * hr + si[j]; hr = nr; hi = ni; }
        }
    }
}

__device__ __forceinline__ int crow(int r, int h) { return (r & 3) + 8 * (r >> 2) + 4 * h; }
constexpr int KST = 272, VST = 320;
__device__ __forceinline__ void phase_attn(const Args& a, LAS unsigned char* lds) {
    unsigned char* ws = a.ws; const int tid = tid_fresh(), lane = tid & 63, w = __builtin_amdgcn_readfirstlane(tid >> 6), l31 = lane & 31, h = lane >> 5;
    const bf16_t* Qg = (const bf16_t*)(ws + WS_Q); const bf16_t* Kg = (const bf16_t*)(ws + WS_K); const bf16_t* Vg = (const bf16_t*)(ws + WS_V); bf16_t* YB = (bf16_t*)(ws + WS_YB8);
    LAS unsigned char* Kl = lds; LAS unsigned char* Vl = lds + 64 * KST; LAS float* wsf = (LAS float*)(lds + 64 * KST + 64 * VST) + w * 64;
    unsigned* qctr = (unsigned*)(ws + 32768);
    LAS volatile unsigned* qslot = (LAS volatile unsigned*)(lds + 64 * KST + 64 * VST + 8 * 256);
    for (;;) {
        __syncthreads();
        if (tid == 0) qslot[0] = __hip_atomic_fetch_add(qctr, 1u, __ATOMIC_RELAXED, __HIP_MEMORY_SCOPE_AGENT);
        __syncthreads();
        const int unit = (int)qslot[0];
        if (unit >= 1024) break;
        const int b = unit >> 8, kvh = (unit >> 7) & 1, qb = unit & 127, q0 = qb * 64;
        const int hq = kvh * 4 + (w >> 1), qi = q0 + 32 * (w & 1) + l31;
        const float slope2 = exp2f(-(float)(hq + 1)) * LOG2E;
        bf16x8 qf[8];
#pragma unroll
        for (int ks = 0; ks < 8; ++ks) qf[ks] = *(const bf16x8*)(Qg + (size_t)(b * SEQ + qi) * 1024 + hq * 128 + ks * 16 + h * 8);
        float mrun = a.sink[hq] * LOG2E, lrun = (h == 0) ? 1.0f : 0.0f;
        f32x16 o[4];
#pragma unroll
        for (int d = 0; d < 4; ++d)
#pragma unroll
            for (int r = 0; r < 16; ++r) o[d][r] = 0.f;
        for (int j = 0; j < 6; ++j) {
            const bool meta = (j == 5); const int ks0 = q0 + 64 * (j - 2);
            if (!meta && (ks0 < 0 || ks0 >= SEQ)) continue;
            __syncthreads();
            {
                const int row = tid >> 3, ch = tid & 7; const int nrows = meta ? 16 : 64;
                if (row < nrows) { const size_t grow = meta ? (size_t)(TOK + row) : (size_t)(b * SEQ + ks0 + row);
                    const u32x4* kp = (const u32x4*)(Kg + grow * 256 + kvh * 128); const u32x4* vp = (const u32x4*)(Vg + grow * 256 + kvh * 128);
                    const u32x4 k0 = kp[ch], k1 = kp[ch + 8], v0 = vp[ch], v1 = vp[ch + 8];
                    *(LAS u32x4*)(Kl + row * KST + ch * 16) = k0; *(LAS u32x4*)(Kl + row * KST + (ch + 8) * 16) = k1;
                    *(LAS u32x4*)(Vl + row * VST + ch * 16) = v0; *(LAS u32x4*)(Vl + row * VST + (ch + 8) * 16) = v1; }
            }
            __syncthreads();
            const int nkb = meta ? 1 : 2;
            f32x16 p[2];
#pragma unroll
            for (int kb = 0; kb < 2; ++kb) { if (kb < nkb) {
#pragma unroll
                for (int r = 0; r < 16; ++r) p[kb][r] = 0.f;
#pragma unroll
                for (int ks = 0; ks < 8; ++ks) { const bf16x8 kf = *(const LAS bf16x8*)(Kl + (32 * kb + l31) * KST + (ks * 16 + h * 8) * 2);
                    p[kb] = __builtin_amdgcn_mfma_f32_32x32x16_bf16(kf, qf[ks], p[kb], 0, 0, 0); } } }
            float mt = -1e30f;
#pragma unroll
            for (int kb = 0; kb < 2; ++kb) { if (kb < nkb) {
#pragma unroll
                for (int r = 0; r < 16; ++r) { const int kk = 32 * kb + crow(r, h); float s = p[kb][r];
                    if (meta) { if (kk >= 16) s = -1e30f; }
                    else { const int dlt = ks0 + kk - qi; const int ad = dlt < 0 ? -dlt : dlt; s = (ad <= 128) ? s - slope2 * (float)ad : -1e30f; }
                    p[kb][r] = s; mt = fmaxf(mt, s); } } }
            mt = fmaxf(mt, __shfl_xor(mt, 32));
            const float mnew = fmaxf(mrun, mt), alpha = __builtin_amdgcn_exp2f(mrun - mnew); mrun = mnew;
            float ls = 0.f;
#pragma unroll
            for (int kb = 0; kb < 2; ++kb) { if (kb < nkb) {
#pragma unroll
                for (int r = 0; r < 16; ++r) { const float e = __builtin_amdgcn_exp2f(p[kb][r] - mnew); p[kb][r] = e; ls += e; } } }
            lrun = lrun * alpha + ls;
            if (h == 0) wsf[l31] = alpha;
            LDS_WAIT();
#pragma unroll
            for (int r = 0; r < 16; ++r) { const float al = wsf[crow(r, h)];
#pragma unroll
                for (int d = 0; d < 4; ++d) o[d][r] *= al; }
            const int gi = lane >> 4, i16 = lane & 15;
#pragma unroll
            for (int kb = 0; kb < 2; ++kb) { if (kb < nkb) {
#pragma unroll
                for (int s = 0; s < 2; ++s) { if (meta && s == 1) continue;
                    union { u32x4 u; bf16x8 v; } pa;
                    pa.u.x = cvt_pk_bf16(p[kb][8 * s + 0], p[kb][8 * s + 1]); pa.u.y = cvt_pk_bf16(p[kb][8 * s + 2], p[kb][8 * s + 3]);
                    pa.u.z = cvt_pk_bf16(p[kb][8 * s + 4], p[kb][8 * s + 5]); pa.u.w = cvt_pk_bf16(p[kb][8 * s + 6], p[kb][8 * s + 7]);
                    const int krow = 32 * kb + 16 * s + 4 * h + (i16 >> 2);
#pragma unroll
                    for (int d = 0; d < 4; ++d) {
                        const LAS unsigned char* vp = Vl + krow * VST + (d * 32 + 16 * (gi & 1) + 4 * (i16 & 3)) * 2;
                        const s16x4 lo = __builtin_amdgcn_ds_read_tr16_b64_v4i16((LAS s16x4*)vp);
                        const s16x4 hi = __builtin_amdgcn_ds_read_tr16_b64_v4i16((LAS s16x4*)(vp + 8 * VST));
                        const bf16x8 vb = {lo[0], lo[1], lo[2], lo[3], hi[0], hi[1], hi[2], hi[3]};
                        o[d] = __builtin_amdgcn_mfma_f32_32x32x16_bf16(pa.v, vb, o[d], 0, 0, 0); } } } }
        }
        lrun += __shfl_xor(lrun, 32);
        LDS_WAIT();
        if (h == 0) wsf[l31] = 1.0f / lrun;
        LDS_WAIT();
#pragma unroll
        for (int r = 0; r < 16; ++r) { const int qr = crow(r, h); const float li = wsf[qr];
            bf16_t* orow = (bf16_t*)((unsigned char*)YB + (size_t)(b * SEQ + q0 + 32 * (w & 1) + qr) * 1024 + hq * 128 + l31);
#pragma unroll
            for (int d = 0; d < 4; ++d) ((unsigned char*)orow)[d * 32] = (unsigned char)(__builtin_amdgcn_cvt_pk_fp8_f32(o[d][r] * li, 0.f, 0, false) & 0xff); }
        LDS_WAIT();
    }
    __syncthreads();
}

__device__ __forceinline__ void ce_desc(unsigned& a, unsigned& b) { const unsigned hi = max(a, b), lo = min(a, b); a = hi; b = lo; }
__device__ __forceinline__ void bitonic_merge16(unsigned (&v)[16]) {
#pragma unroll
    for (int j = 8; j > 0; j >>= 1)
#pragma unroll
        for (int i = 0; i < 16; ++i) { const int l = i ^ j; if (l > i) ce_desc(v[i], v[l]); }
}
__device__ __forceinline__ void bitonic_sort16(unsigned (&v)[16]) {
#pragma unroll
    for (int k = 2; k <= 16; k <<= 1)
#pragma unroll
        for (int j = k >> 1; j > 0; j >>= 1)
#pragma unroll
            for (int i = 0; i < 16; ++i) { const int l = i ^ j; if (l > i) { if (((i & k) == 0) || k == 16) ce_desc(v[i], v[l]); else ce_desc(v[l], v[i]); } }
}
__device__ __forceinline__ void top16_merge(unsigned (&r)[16], const unsigned (&g)[16]) {
#pragma unroll
    for (int i = 0; i < 16; ++i) r[i] = max(r[i], g[15 - i]);
    bitonic_merge16(r);
}
__device__ __forceinline__ unsigned f2ord(float f) { const unsigned u = __float_as_uint(f); return u ^ ((u >> 31) ? 0xffffffffu : 0x80000000u); }
__device__ __forceinline__ void phase_topk(const Args& a, LAS unsigned char* lds) {
    unsigned char* ws = a.ws; const int tid = tid_fresh(), lane = tid & 63, w = __builtin_amdgcn_readfirstlane(tid >> 6), fr = lane & 15, fq = lane >> 4;
    const bf16_t* QP = (const bf16_t*)(ws + WS_QP); const bf16_t* PK = (const bf16_t*)(ws + WS_PK);
    int* EIDX = (int*)(ws + WS_EIDX); float* EGATE = (float*)(ws + WS_EGATE); const float* RSS = (const float*)(ws + WS_RSS);
    constexpr int AST = 528, BST = 272;
    LAS unsigned char* Al = lds; LAS unsigned char* Bl = lds + 128 * AST;
    LAS float* sc = (LAS float*)lds;
    LAS unsigned* kl = (LAS unsigned*)(lds + 131584 + 64);
    u32x4 pfa[8], pfb[8];
#define TK_FETCH(u_) do { const int tt_ = (u_) >> 3, hd_ = (u_) & 7; _Pragma("unroll") for (int q_ = 0; q_ < 8; ++q_) { const int i_ = tid + q_ * NTHREADS; \
        { const int row = i_ >> 5, ch = i_ & 31; pfa[q_] = *(const u32x4*)(QP + (size_t)(tt_ * 128 + row) * 2048 + hd_ * 256 + ch * 8); } \
        { const int row = i_ >> 4, ch = i_ & 15; pfb[q_] = *(const u32x4*)(PK + (size_t)(row >> 7) * 131072 + ((size_t)hd_ * 128 + (row & 127)) * 128 + ch * 8); } } } while (0)
    pg::StaticOrder SO; SO.init(TOK, 2048, (int)gridDim.x, (int)blockIdx.x);
#define TK_UNIT(j_) ({ pg::Unit u_; int r_ = -1; if (SO.next((j_) >> 1, u_)) r_ = (2 * u_.pm + ((j_) & 1)) * 8 + u_.pn; r_; })
    int unit = TK_UNIT(0), jn = 1;
    if (unit >= 0) TK_FETCH(unit);
    for (; unit >= 0; ) {
        const int tt = unit >> 3, hd = unit & 7, t0 = tt * 128;
        __syncthreads();
#pragma unroll
        for (int q_ = 0; q_ < 8; ++q_) { const int i_ = tid + q_ * NTHREADS;
            { const int row = i_ >> 5, ch = i_ & 31; *(LAS u32x4*)(Al + row * AST + ch * 16) = pfa[q_]; }
            { const int row = i_ >> 4, ch = i_ & 15; *(LAS u32x4*)(Bl + row * BST + ch * 16) = pfb[q_]; } }
        __syncthreads();
        const int unit_next = TK_UNIT(jn); ++jn;
        if (unit_next >= 0) TK_FETCH(unit_next);
        f32x4 acc[2][8];
#pragma unroll
        for (int hf = 0; hf < 2; ++hf)
#pragma unroll
            for (int nb = 0; nb < 8; ++nb) acc[hf][nb] = (f32x4){0.f, 0.f, 0.f, 0.f};
#pragma unroll
        for (int hf = 0; hf < 2; ++hf)
#pragma unroll
            for (int ks = 0; ks < 4; ++ks) { const bf16x8 af = *(const LAS bf16x8*)(Al + (16 * w + fr) * AST + (hf * 128 + ks * 32 + fq * 8) * 2);
#pragma unroll
                for (int nb = 0; nb < 8; ++nb) { const bf16x8 bfr = *(const LAS bf16x8*)(Bl + (hf * 128 + nb * 16 + fr) * BST + (ks * 32 + fq * 8) * 2);
                    acc[hf][nb] = __builtin_amdgcn_mfma_f32_16x16x32_bf16(af, bfr, acc[hf][nb], 0, 0, 0); } }
        float rsr[4];
#pragma unroll
        for (int r = 0; r < 4; ++r) { const f32x4* rp = (const f32x4*)(RSS + (size_t)(t0 + 16 * w + 4 * fq + r) * 32); float ssum = 0.f;
#pragma unroll
            for (int j = 0; j < 8; ++j) { const f32x4 t = rp[j]; ssum += (t[0] + t[1]) + (t[2] + t[3]); }
            rsr[r] = 1.0f / sqrtf(ssum * (1.0f / 2048.0f) + NORM_EPS); }
        __syncthreads();
#pragma unroll
        for (int hf = 0; hf < 2; ++hf)
#pragma unroll
            for (int nb = 0; nb < 8; ++nb)
#pragma unroll
                for (int r = 0; r < 4; ++r) sc[(16 * w + 4 * fq + r) * 257 + hf * 128 + nb * 16 + fr] = acc[hf][nb][r] * rsr[r];
        __syncthreads();
        {
            const int tok = 16 * w + (lane & 15), hf = (lane >> 4) & 1, part = lane >> 5; unsigned R[16], Gq[16];
            const LAS float* sp = sc + tok * 257 + hf * 128 + part * 64;
#pragma unroll
            for (int gi = 0; gi < 4; ++gi) {
#pragma unroll
                for (int j = 0; j < 16; ++j) { const int n = gi * 16 + j; Gq[j] = (f2ord(sp[n]) & ~127u) | (unsigned)(127 - (part * 64 + n)); }
                bitonic_sort16(Gq);
                if (gi == 0) {
#pragma unroll
                    for (int j = 0; j < 16; ++j) R[j] = Gq[j];
                } else top16_merge(R, Gq);
            }
#pragma unroll
            for (int j = 0; j < 16; ++j) Gq[j] = (unsigned)__shfl_xor((int)R[j], 32);
            top16_merge(R, Gq);
            if (part == 0) {
#pragma unroll
                for (int j = 0; j < 16; ++j) kl[(tok * 2 + hf) * 16 + j] = R[j]; }
        }
        __syncthreads();
        if (tid < 128) {
            const int tok = tid; unsigned L[16], Gq[16];
            float v1[16], v2[16];
#pragma unroll
            for (int j = 0; j < 16; ++j) { const int n1 = 127 - (int)(kl[(tok * 2) * 16 + j] & 127u), n2 = 127 - (int)(kl[(tok * 2 + 1) * 16 + j] & 127u);
                v1[j] = sc[tok * 257 + n1]; v2[j] = sc[tok * 257 + 128 + n2]; }
            {
                int cnt = 0, grp = 0;
#pragma unroll
                for (int j = 0; j < 16; ++j) Gq[j] = 0u;
#pragma unroll
                for (int i = 0; i < 16; ++i)
#pragma unroll
                    for (int j = 0; j < 16; ++j) if ((i + 1) * (j + 1) <= 16) {
                        Gq[cnt & 15] = (f2ord(v1[i] + v2[j]) & ~255u) | (unsigned)(255 - (i * 16 + j)); ++cnt;
                        if ((cnt & 15) == 0 || cnt == 50) { bitonic_sort16(Gq);
                            if (grp == 0) {
#pragma unroll
                                for (int q = 0; q < 16; ++q) L[q] = Gq[q];
                            } else top16_merge(L, Gq);
                            ++grp;
#pragma unroll
                            for (int q = 0; q < 16; ++q) Gq[q] = 0u; } }
            }
            float sv[16]; int ei[16]; float mx = -1e30f;
#pragma unroll
            for (int q = 0; q < 16; ++q) { const int ci = 255 - (int)(L[q] & 255u), i = ci >> 4, j = ci & 15;
                const int n1 = 127 - (int)(kl[(tok * 2) * 16 + i] & 127u), n2 = 127 - (int)(kl[(tok * 2 + 1) * 16 + j] & 127u);
                sv[q] = sc[tok * 257 + n1] + sc[tok * 257 + 128 + n2]; ei[q] = n1 * 128 + n2; mx = fmaxf(mx, sv[q]); }
            float sum = 0.f;
#pragma unroll
            for (int q = 0; q < 16; ++q) { sv[q] = __builtin_amdgcn_exp2f((sv[q] - mx) * LOG2E); sum += sv[q]; }
            const float inv = 1.0f / sum; const size_t ob = ((size_t)(t0 + tok) * 8 + hd) * 16;
#pragma unroll
            for (int q = 0; q < 4; ++q) { *(int4*)(EIDX + ob + 4 * q) = make_int4(ei[4 * q], ei[4 * q + 1], ei[4 * q + 2], ei[4 * q + 3]);
                *(f32x4*)(EGATE + ob + 4 * q) = (f32x4){sv[4 * q] * inv, sv[4 * q + 1] * inv, sv[4 * q + 2] * inv, sv[4 * q + 3] * inv}; }
        }
        unit = unit_next;
    }
    __syncthreads();
}

#define DPP_ROR_ADD(v, n) ((v) + __uint_as_float(__builtin_amdgcn_update_dpp(0, __float_as_uint(v), 0x120 + (n), 0xf, 0xf, false)))
__device__ __forceinline__ float reduce4(float p0, float p1, float p2, float p3) {
    const auto s01 = __builtin_amdgcn_permlane32_swap(__float_as_uint(p0), __float_as_uint(p1), false, false);
    const auto s23 = __builtin_amdgcn_permlane32_swap(__float_as_uint(p2), __float_as_uint(p3), false, false);
    const float r01 = __uint_as_float(s01[0]) + __uint_as_float(s01[1]), r23 = __uint_as_float(s23[0]) + __uint_as_float(s23[1]);
    const auto t = __builtin_amdgcn_permlane16_swap(__float_as_uint(r01), __float_as_uint(r23), false, false);
    float r = __uint_as_float(t[0]) + __uint_as_float(t[1]);
    r = DPP_ROR_ADD(r, 8); r = DPP_ROR_ADD(r, 4); r = DPP_ROR_ADD(r, 2); r = DPP_ROR_ADD(r, 1);
    return r;
}
__device__ __forceinline__ float dot16_fp8(const u32x4 q, const f32x2* h, float acc) {
    f32x2 s = {acc, 0.f};
#pragma unroll
    for (int j = 0; j < 4; ++j) { const unsigned d = q[j]; const f32x2 lo = __builtin_amdgcn_cvt_pk_f32_fp8(d, false), hi = __builtin_amdgcn_cvt_pk_f32_fp8(d, true);
        s = __builtin_elementwise_fma(lo, h[2 * j], s); s = __builtin_elementwise_fma(hi, h[2 * j + 1], s); }
    return s.x + s.y;
}
__device__ __forceinline__ void axpy16_fp8(const u32x4 q, const float w, f32x2* acc) {
    const f32x2 ww = {w, w};
#pragma unroll
    for (int j = 0; j < 4; ++j) { const unsigned d = q[j]; const f32x2 lo = __builtin_amdgcn_cvt_pk_f32_fp8(d, false), hi = __builtin_amdgcn_cvt_pk_f32_fp8(d, true);
        acc[2 * j] = __builtin_elementwise_fma(lo, ww, acc[2 * j]); acc[2 * j + 1] = __builtin_elementwise_fma(hi, ww, acc[2 * j + 1]); }
}
struct Row6 { u32x4 a; u32x2 b; };
__device__ __forceinline__ void axpy32_fp6(const Row6& q, const float w, f32x2* acc) {
    const u32x6 v = {q.a[0], q.a[1], q.a[2], q.a[3], q.b[0], q.b[1]};
    const f32x32 f = FMT6 == 0 ? __builtin_amdgcn_cvt_scalef32_pk32_f32_bf6(v, 1.0f) : __builtin_amdgcn_cvt_scalef32_pk32_f32_fp6(v, 1.0f); const f32x2 ww = {w, w};
#pragma unroll
    for (int j = 0; j < 16; ++j) acc[j] = __builtin_elementwise_fma((f32x2){f[2 * j], f[2 * j + 1]}, ww, acc[j]);
}
struct Row4 { u32x4 q; unsigned s; };
__device__ __forceinline__ void axpy32_fp4(const Row4& r, const float w, f32x2* acc) {
    const float ws_ = w * __uint_as_float((r.s << 20) + ((unsigned)SC4_BIAS << 20)); const float scale = 1.0f; const f32x2 ww = {ws_, ws_};
#pragma unroll
    for (int d = 0; d < 4; ++d) { const unsigned x = r.q[d];
        acc[4 * d + 0] = __builtin_elementwise_fma(__builtin_amdgcn_cvt_scalef32_pk_f32_fp4(x, scale, 0), ww, acc[4 * d + 0]);
        acc[4 * d + 1] = __builtin_elementwise_fma(__builtin_amdgcn_cvt_scalef32_pk_f32_fp4(x, scale, 1), ww, acc[4 * d + 1]);
        acc[4 * d + 2] = __builtin_elementwise_fma(__builtin_amdgcn_cvt_scalef32_pk_f32_fp4(x, scale, 2), ww, acc[4 * d + 2]);
        acc[4 * d + 3] = __builtin_elementwise_fma(__builtin_amdgcn_cvt_scalef32_pk_f32_fp4(x, scale, 3), ww, acc[4 * d + 3]); }
}
__device__ __forceinline__ float dot32_fp4(const Row4& r, const f32x2* h) {
    const float scale = 1.0f;
    f32x2 s0 = {0.f, 0.f}, s1 = {0.f, 0.f};
    asm volatile("" : "+v"(s0), "+v"(s1));
#pragma unroll
    for (int d = 0; d < 4; ++d) { const unsigned x = r.q[d];
        s0 = __builtin_elementwise_fma(__builtin_amdgcn_cvt_scalef32_pk_f32_fp4(x, scale, 0), h[4 * d + 0], s0);
        s1 = __builtin_elementwise_fma(__builtin_amdgcn_cvt_scalef32_pk_f32_fp4(x, scale, 1), h[4 * d + 1], s1);
        s0 = __builtin_elementwise_fma(__builtin_amdgcn_cvt_scalef32_pk_f32_fp4(x, scale, 2), h[4 * d + 2], s0);
        s1 = __builtin_elementwise_fma(__builtin_amdgcn_cvt_scalef32_pk_f32_fp4(x, scale, 3), h[4 * d + 3], s1); }
    return ((s0.x + s0.y) + (s1.x + s1.y)) * __uint_as_float((r.s << 20) + ((unsigned)SC4_BIAS << 20));
}
__device__ __forceinline__ float dot32_fp6(const Row6& q, const f32x2* h) {
    const u32x6 v = {q.a[0], q.a[1], q.a[2], q.a[3], q.b[0], q.b[1]};
    f32x2 s0 = {0.f, 0.f}, s1 = {0.f, 0.f};
    const f32x32 f = FMT6 == 0 ? __builtin_amdgcn_cvt_scalef32_pk32_f32_bf6(v, 1.0f) : __builtin_amdgcn_cvt_scalef32_pk32_f32_fp6(v, 1.0f);
    asm volatile("" : "+v"(s0), "+v"(s1));
#pragma unroll
    for (int j = 0; j < 16; j += 2) { s0 = __builtin_elementwise_fma((f32x2){f[2 * j], f[2 * j + 1]}, h[j], s0); s1 = __builtin_elementwise_fma((f32x2){f[2 * j + 2], f[2 * j + 3]}, h[j + 1], s1); }
    return (s0.x + s0.y) + (s1.x + s1.y);
}

__device__ __forceinline__ void phase_x8(const Args& a) {
    unsigned char* ws = a.ws; const int tid = tid_fresh(), lane = tid & 63, wave = tid >> 6;
    const bf16_t* H2U = (const bf16_t*)(ws + WS_H2U); const float* RSS = (const float*)(ws + WS_RSS);
    unsigned char* X8G = ws + WS_X8G; float* XSCL = (float*)(ws + WS_XSCL);
    const int gw = blockIdx.x * NWAVES + wave, NGW = gridDim.x * NWAVES;
#pragma unroll 1
    for (int tb = gw * 4; tb < TOK; tb += NGW * 4) {
        u32x2 raw[4][8]; float rsq[4], am[4];
#pragma unroll
        for (int t = 0; t < 4; ++t) { const size_t tok = (size_t)(tb + t);
#pragma unroll
            for (int j = 0; j < 8; ++j) raw[t][j] = *(const u32x2*)(H2U + tok * 2048 + (j * 64 + lane) * 4);
            rsq[t] = (lane < 32) ? RSS[tok * 32 + lane] : 0.f; }
#pragma unroll
        for (int t = 0; t < 4; ++t) { float m = 0.f;
#pragma unroll
            for (int j = 0; j < 8; ++j) m = fmaxf(m, fmaxf(fmaxf(fabsf(bf_lo(raw[t][j].x)), fabsf(bf_hi(raw[t][j].x))), fmaxf(fabsf(bf_lo(raw[t][j].y)), fabsf(bf_hi(raw[t][j].y)))));
            am[t] = m; }
#pragma unroll
        for (int o = 1; o < 64; o <<= 1) {
#pragma unroll
            for (int t = 0; t < 4; ++t) { am[t] = fmaxf(am[t], __shfl_xor(am[t], o)); rsq[t] += __shfl_xor(rsq[t], o); } }
#pragma unroll
        for (int t = 0; t < 4; ++t) { const size_t tok = (size_t)(tb + t);
            const float rs2 = 1.0f / sqrtf(rsq[t] * (1.0f / 2048.0f) + NORM_EPS);
            float sc = 1.0f, isc = 1.0f;
            if (am[t] > 0.f) { const float e = fminf(fmaxf(floorf(log2f(256.0f / am[t])), -100.f), 100.f); sc = exp2f(e); isc = exp2f(-e); }
            u32x4 w0, w1;
#pragma unroll
            for (int j = 0; j < 8; ++j) { int pk = __builtin_amdgcn_cvt_pk_fp8_f32(bf_lo(raw[t][j].x) * sc, bf_hi(raw[t][j].x) * sc, 0, false);
                pk = __builtin_amdgcn_cvt_pk_fp8_f32(bf_lo(raw[t][j].y) * sc, bf_hi(raw[t][j].y) * sc, pk, true);
                if (j < 4) w0[j] = (unsigned)pk; else w1[j - 4] = (unsigned)pk; }
            *(u32x4*)(X8G + tok * 2048 + lane * 32) = w0; *(u32x4*)(X8G + tok * 2048 + lane * 32 + 16) = w1;
            if (lane == 0) XSCL[tok] = isc * rs2; }
    }
}
#if UFMT4
typedef Row4 RowU;
__device__ __forceinline__ float dot32_u(const Row4& r, const f32x2* h) {
    return dot32_fp4(r, h);
}
__device__ __forceinline__ void g_load_row(Row4& d, const __amdgpu_buffer_rsrc_t rsT, const __amdgpu_buffer_rsrc_t rsS, int lane, int e) {
    d.q = __builtin_amdgcn_raw_buffer_load_b128(rsT, lane * 16, e * 1024, 0); d.s = (unsigned)__builtin_amdgcn_raw_buffer_load_b8(rsS, lane, e * 64, 0); }
#else
typedef Row6 RowU;
__device__ __forceinline__ float dot32_u(const Row6& r, const f32x2* h) { return dot32_fp6(r, h); }
__device__ __forceinline__ void g_load_row(Row6& d, const __amdgpu_buffer_rsrc_t rsT, const __amdgpu_buffer_rsrc_t rsS, int lane, int e) {
    d.a = __builtin_amdgcn_raw_buffer_load_b128(rsT, lane * 16, e * 1536, 0); d.b = __builtin_amdgcn_raw_buffer_load_b64(rsT, 1024 + lane * 8, e * 1536, 0); }
#endif
__device__ __forceinline__ void phase_gather(const Args& a) {
    unsigned char* ws = a.ws; const int tid = tid_fresh(), lane = tid & 63, wave = tid >> 6;
    const bf16_t* H2U = (const bf16_t*)(ws + WS_H2U); const unsigned char* UT = ws + WS_UT; const unsigned char* VT = ws + WS_VT;
    const float* ISU = (const float*)(ws + WS_ISU); const float* ISV = (const float*)(ws + WS_ISV);
    const int* EIDX = (const int*)(ws + WS_EIDX); const float* EGATE = (const float*)(ws + WS_EGATE); const float* RSS = (const float*)(ws + WS_RSS);
    const int gw = blockIdx.x * NWAVES + wave, NGW = gridDim.x * NWAVES;
    const __amdgpu_buffer_rsrc_t rsUT = __builtin_amdgcn_make_buffer_rsrc((void*)UT, 0, 24 << 20, 0x00020000), rsVT = __builtin_amdgcn_make_buffer_rsrc((void*)VT, 0, 16 << 20, 0x00020000), rsVS = __builtin_amdgcn_make_buffer_rsrc((void*)(ws + WS_ISV), 0, 1 << 20, 0x00020000), rsUS = __builtin_amdgcn_make_buffer_rsrc((void*)(ws + WS_ISU), 0, 1 << 20, 0x00020000);
#if DOTS_PROBE
    { const float V = *(const float*)(ws + WS_DOTS);
        for (int tok = gw; tok < TOK; tok += NGW) { float* orow = a.out + (size_t)tok * 2048;
#pragma unroll
            for (int j = 0; j < 8; ++j) *(f32x4*)(orow + (j * 64 + lane) * 4) = (f32x4){V, V, V, V}; }
        return; }
#endif
    if (DBG & 64) {
        const float lv[8] = {0.f, 0.5f, 1.f, 1.5f, 2.f, 3.f, 4.f, 6.f};
        unsigned v1 = 0x76543210u, v2 = 0xFEDCBA98u; asm volatile("" : "+v"(v1), "+v"(v2)); float one = 1.0f, quarter = 0.25f; asm volatile("" : "+v"(one), "+v"(quarter));
        int n1 = 0, n2 = 0, n3 = 0;
#define PB(sel) { const f32x2 a_ = __builtin_amdgcn_cvt_scalef32_pk_f32_fp4(v1, one, sel), b_ = __builtin_amdgcn_cvt_scalef32_pk_f32_fp4(v2, one, sel), c_ = __builtin_amdgcn_cvt_scalef32_pk_f32_fp4(v1, quarter, sel); \
            n1 += (a_.x != lv[2 * sel]) + (a_.y != lv[2 * sel + 1]); n2 += (b_.x != -lv[2 * sel]) + (b_.y != -lv[2 * sel + 1]); n3 += (c_.x != 0.25f * lv[2 * sel]) + (c_.y != 0.25f * lv[2 * sel + 1]); }
        PB(0) PB(1) PB(2) PB(3)
#undef PB
        const float V = sqrtf((float)(n1 + 10 * n2 + 100 * n3));
        for (int tok = gw; tok < TOK; tok += NGW) { float* orow = a.out + (size_t)tok * 2048;
#pragma unroll
            for (int j = 0; j < 8; ++j) *(f32x4*)(orow + (j * 64 + lane) * 4) = (f32x4){V, V, V, V}; }
        return;
    }
    for (int tq = gw * 8; tq < TOK; tq = ((tq & 7) == 7) ? tq - 7 + NGW * 8 : tq + 1) { const int tok = tq;
        float rs2; { float s = (lane < 32) ? RSS[(size_t)tok * 32 + lane] : 0.f; s = wave_sum(s); rs2 = 1.0f / sqrtf(s * (1.0f / 2048.0f) + NORM_EPS); }
        const int e_lo = EIDX[(size_t)tok * 128 + lane], e_hi = EIDX[(size_t)tok * 128 + 64 + lane];
        const float c1_lo = UFMT4 ? rs2 : rs2 * ISU[e_lo], c1_hi = UFMT4 ? rs2 : rs2 * ISU[e_hi];
        const float c2_lo = EGATE[(size_t)tok * 128 + lane], c2_hi = EGATE[(size_t)tok * 128 + 64 + lane];
        float w_lo = 0.f, w_hi = 0.f;
#if MFMA_A
        w_lo = c2_lo * gelu_tanh(((const float*)(ws + WS_DOTS))[(size_t)tok * 128 + lane]); w_hi = c2_hi * gelu_tanh(((const float*)(ws + WS_DOTS))[(size_t)tok * 128 + 64 + lane]);
        (void)c1_lo; (void)c1_hi;
#else
        f32x2 h[16];
#pragma unroll
        for (int j = 0; j < 8; ++j) { const u32x2 q = *(const u32x2*)(H2U + (size_t)tok * 2048 + (j * 64 + lane) * 4); h[2 * j] = (f32x2){bf_lo(q.x), bf_hi(q.x)}; h[2 * j + 1] = (f32x2){bf_lo(q.y), bf_hi(q.y)}; }
#define G_LOAD(dst, TAB, k) do { const int ev_ = (k) < 64 ? e_lo : e_hi; _Pragma("unroll") for (int kk = 0; kk < 8; ++kk) { \
            const int e_ = __builtin_amdgcn_readlane(ev_, ((k) & 63) + kk); g_load_row(dst[kk], rs##TAB, rsUS, lane, e_); } } while (0)
#define G_DOTS(src, k) do { float p[4]; _Pragma("unroll") for (int kk = 0; kk < 4; ++kk) { p[kk] = dot32_u(src[kk], h); __builtin_amdgcn_sched_barrier(0); } \
            const float r0 = reduce4(p[0], p[1], p[2], p[3]); __builtin_amdgcn_sched_barrier(0); \
            _Pragma("unroll") for (int kk = 0; kk < 4; ++kk) { p[kk] = dot32_u(src[4 + kk], h); __builtin_amdgcn_sched_barrier(0); } \
            const float r1 = reduce4(p[0], p[1], p[2], p[3]); float t[8]; \
            t[0] = __uint_as_float(__builtin_amdgcn_readlane(__float_as_uint(r0), 0)); t[2] = __uint_as_float(__builtin_amdgcn_readlane(__float_as_uint(r0), 16)); \
            t[1] = __uint_as_float(__builtin_amdgcn_readlane(__float_as_uint(r0), 32)); t[3] = __uint_as_float(__builtin_amdgcn_readlane(__float_as_uint(r0), 48)); \
            t[4] = __uint_as_float(__builtin_amdgcn_readlane(__float_as_uint(r1), 0)); t[6] = __uint_as_float(__builtin_amdgcn_readlane(__float_as_uint(r1), 16)); \
            t[5] = __uint_as_float(__builtin_amdgcn_readlane(__float_as_uint(r1), 32)); t[7] = __uint_as_float(__builtin_amdgcn_readlane(__float_as_uint(r1), 48)); \
            float nv = 0.f; const int lk = lane - ((k) & 63); _Pragma("unroll") for (int kk = 0; kk < 8; ++kk) nv = (lk == kk) ? t[kk] : nv; \
            if ((k) < 64) { if ((unsigned)lk < 8u) w_lo = nv; } else { if ((unsigned)lk < 8u) w_hi = nv; } } while (0)
#define G_AXPY(src, k) do { const float wv_ = (k) < 64 ? w_lo : w_hi; _Pragma("unroll") for (int kk = 0; kk < 8; ++kk) { \
            const float wk_ = __uint_as_float(__builtin_amdgcn_readlane(__float_as_uint(wv_), ((k) & 63) + kk)); axpy16_fp8(src[kk][0], wk_, acc); axpy16_fp8(src[kk][1], wk_, acc + 8); \
            if ((kk & 1) == 1) __builtin_amdgcn_sched_barrier(0); } } while (0)
        RowU bufA[8], bufB[8];
        G_LOAD(bufA, UT, 0);
#pragma unroll 1
        for (int k0 = 0; k0 < 128; k0 += 16) {
            G_LOAD(bufB, UT, k0 + 8); __builtin_amdgcn_sched_barrier(0);
            G_DOTS(bufA, k0); __builtin_amdgcn_sched_barrier(0);
            if (k0 + 16 < 128) G_LOAD(bufA, UT, k0 + 16);
            __builtin_amdgcn_sched_barrier(0);
            G_DOTS(bufB, k0 + 8); __builtin_amdgcn_sched_barrier(0);
        }
        w_lo = c2_lo * gelu_tanh(w_lo * c1_lo); w_hi = c2_hi * gelu_tanh(w_hi * c1_hi);
#endif
        if (DBG & 2) { w_lo = 0.f; w_hi = 0.f; }
#define V_LOAD(dst, k) do { const int ev_ = (k) < 64 ? e_lo : e_hi; _Pragma("unroll") for (int kk = 0; kk < 8; ++kk) { \
            const int e_ = __builtin_amdgcn_readlane(ev_, ((k) & 63) + kk); dst[kk].q = __builtin_amdgcn_raw_buffer_load_b128(rsVT, lane * 16, e_ * 1024, 0); \
            dst[kk].s = (unsigned)__builtin_amdgcn_raw_buffer_load_b8(rsVS, lane, e_ * 64, 0); } } while (0)
#define V_AXPY(src, k) do { const float wv_ = (k) < 64 ? w_lo : w_hi; _Pragma("unroll") for (int kk = 0; kk < 8; ++kk) { \
            const float wk_ = __uint_as_float(__builtin_amdgcn_readlane(__float_as_uint(wv_), ((k) & 63) + kk)); axpy32_fp4(src[kk], wk_, acc); \
            __builtin_amdgcn_sched_barrier(0); } } while (0)
        f32x2 acc[16];
#pragma unroll
        for (int j = 0; j < 16; ++j) acc[j] = (f32x2){0.f, 0.f};
        Row4 vA[8], vB[8];
        V_LOAD(vA, 0);
#pragma unroll 1
        for (int k0 = 0; k0 < 128; k0 += 16) {
            V_LOAD(vB, k0 + 8); __builtin_amdgcn_sched_barrier(0);
            V_AXPY(vA, k0); __builtin_amdgcn_sched_barrier(0);
            if (k0 + 16 < 128) V_LOAD(vA, k0 + 16);
            __builtin_amdgcn_sched_barrier(0);
            V_AXPY(vB, k0 + 8); __builtin_amdgcn_sched_barrier(0);
        }
#undef V_LOAD
#undef V_AXPY
#undef G_LOAD
#undef G_DOTS
#undef G_AXPY
        float ss = 0.f;
#pragma unroll
        for (int j = 0; j < 8; ++j) { const u32x2 q = *(const u32x2*)(H2U + (size_t)tok * 2048 + (j * 64 + lane) * 4); f32x2& a0 = acc[2 * j]; f32x2& a1 = acc[2 * j + 1];
            a0.x += bf_lo(q.x); a0.y += bf_hi(q.x); a1.x += bf_lo(q.y); a1.y += bf_hi(q.y); ss += (a0.x * a0.x + a0.y * a0.y) + (a1.x * a1.x + a1.y * a1.y); }
        const float rs = 1.0f / sqrtf(wave_sum(ss) * (1.0f / 2048.0f) + NORM_EPS);
        float* orow = a.out + (size_t)tok * 2048;
#pragma unroll
        for (int j = 0; j < 8; ++j) { const f32x4 gq = *(const f32x4*)(a.norm_final + (j * 64 + lane) * 4); const f32x2 a0 = acc[2 * j], a1 = acc[2 * j + 1];
            *(f32x4*)(orow + (j * 64 + lane) * 4) = (f32x4){a0.x * rs * gq[0], a0.y * rs * gq[1], a1.x * rs * gq[2], a1.y * rs * gq[3]}; }
    }
}

#define XB_TMO      128
#define XB_XCNT(j)  (256  + 64 * (j))
#define XB_XSUB(j)  (1280 + 64 * (j))
#define XB_XGEN(j)  (2304 + 64 * (j))
#define XB_TOP      3328
#define XB_TOPGEN   3392
#define XCD_BAR_WORDS 3456
#define XB_SPIN_CAP (1u << 20)
__device__ __forceinline__ unsigned xb_ld(unsigned* p)              { return __hip_atomic_load(p, __ATOMIC_RELAXED, __HIP_MEMORY_SCOPE_AGENT); }
__device__ __forceinline__ unsigned xb_add(unsigned* p, unsigned v) { return __hip_atomic_fetch_add(p, v, __ATOMIC_RELAXED, __HIP_MEMORY_SCOPE_AGENT); }
__device__ __forceinline__ unsigned xb_xcc_id() { return (unsigned)__builtin_amdgcn_s_getreg((3 << 11) | 20) & 0xFu; }
#define XB_SPIN(cond, bar) do { unsigned _sp = 0; while (cond) { __builtin_amdgcn_s_sleep(1); \
    if ((++_sp & 255u) == 0u) { if (xb_ld(&(bar)[XB_TMO])) break; if (_sp > XB_SPIN_CAP) { atomicAdd(&(bar)[XB_TMO], 1u); break; } } } } while (0)
struct XcdBarrier { unsigned* bar; unsigned x; volatile LAS unsigned* st; };
__device__ __forceinline__ XcdBarrier xcd_barrier_post(unsigned* bar, volatile LAS unsigned* st) {
    XcdBarrier b; b.bar = bar; b.x = xb_xcc_id(); b.st = st;
    if (threadIdx.x == 0) (void)xb_add(&bar[XB_XCNT(b.x)], 1u);
    return b;
}
__device__ __forceinline__ void xcd_barrier_complete(unsigned* bar, unsigned x, unsigned& nloc, unsigned& nx) {
    const unsigned G = gridDim.x * gridDim.y * gridDim.z;
    unsigned sum, cnt, mine, sp = 0u;
    for (;;) {
        sum = 0u; cnt = 0u; mine = 0u;
#pragma unroll
        for (unsigned j = 0; j < 16; ++j) { const unsigned c = xb_ld(&bar[XB_XCNT(j)]); sum += c; cnt += (c > 0u) ? 1u : 0u; mine = (j == x) ? c : mine; }
        if (sum == G) break;
        __builtin_amdgcn_s_sleep(1);
        if ((++sp & 255u) == 0u) { if (xb_ld(&bar[XB_TMO])) break; if (sp > XB_SPIN_CAP) { atomicAdd(&bar[XB_TMO], 1u); break; } }
    }
    nloc = mine > 0u ? mine : 1u; nx = cnt > 0u ? cnt : 1u;
}
__device__ __forceinline__ void xcd_barrier(const XcdBarrier& b) {
    asm volatile("s_waitcnt vmcnt(0)" ::: "memory");
    __syncthreads();
    if (threadIdx.x == 0) {
        unsigned* bar = b.bar;
        __builtin_amdgcn_s_waitcnt(0);
        unsigned nloc = b.st[0], nx = b.st[1];
        if (nloc == 0u) { xcd_barrier_complete(bar, b.x, nloc, nx); b.st[0] = nloc; b.st[1] = nx; }
        const unsigned old = xb_add(&bar[XB_XSUB(b.x)], 1u);
        const unsigned gen = old / nloc;
        if (old + 1u == (gen + 1u) * nloc) {
            __builtin_amdgcn_fence(__ATOMIC_RELEASE, "agent");
            asm volatile("s_waitcnt vmcnt(0)" ::: "memory");
            const unsigned og = xb_add(&bar[XB_TOP], 1u);
            const unsigned tg = og / nx;
            if (og + 1u == (tg + 1u) * nx) xb_add(&bar[XB_TOPGEN], 1u);
            else XB_SPIN(xb_ld(&bar[XB_TOPGEN]) == tg, bar);
            __builtin_amdgcn_fence(__ATOMIC_ACQUIRE, "agent");
            xb_add(&bar[XB_XGEN(b.x)], 1u);
            asm volatile("s_waitcnt vmcnt(0)" ::: "memory");
        } else {
            XB_SPIN(xb_ld(&bar[XB_XGEN(b.x)]) == gen, bar);
            __builtin_amdgcn_fence(__ATOMIC_ACQUIRE, "agent");
            asm volatile("s_waitcnt vmcnt(0)" ::: "memory");
        }
    }
    __syncthreads();
}

constexpr int DOT_TS = 2064;
constexpr int DOT_CH = 4;
constexpr int DOT_WAVE_LDS = 19968;
#define DG_BLD(B_, st) { B_[0] = *(const LAS u32x4*)(xb_ + (st) * 128); B_[1] = *(const LAS u32x4*)(xb_ + (st) * 128 + 64); }
#define DG_ALD(dst, vo, off) asm volatile("buffer_load_dwordx4 %0, %1, %2, 0 offen offset:%3" : "=v"(dst) : "v"(vo), "s"(rsUT4), "n"(off) : "memory")
#define DG_SLD(dst, vo) asm volatile("buffer_load_dwordx4 %0, %1, %2, 0 offen" : "=v"(dst) : "v"(vo), "s"(rsUS4) : "memory")
#define DG_PERM(s_, PF) { asm volatile("s_waitcnt vmcnt(%1)" : "+v"(A_[s_]) : "n"((PF) ? 20 : 19 - (s_)) : "memory"); \
        if (tmode & 64) P_[(s_) & 3] = A_[s_]; else { *(LAS u32x4*)stw_ = A_[s_]; P_[(s_) & 3] = *(const LAS u32x4*)str_; }     \
        if ((PF) && !(tmode & 128)) DG_ALD(A_[s_], vo_n, (s_) * 64); }
#define DG_STEP(Bc, Bn, st, PF) { if ((st) < 13 && !(tmode & 64)) DG_BLD(Bn, (st) + 3) if ((st) < 14) DG_PERM((st) + 2, PF) __builtin_amdgcn_sched_barrier(0); \
        if (tmode & 64) { acc_[(st) & 3] += __uint_as_float(P_[(st) & 3][0] ^ P_[(st) & 3][1] ^ P_[(st) & 3][2] ^ P_[(st) & 3][3]); } else \
        { const i32x8 av_ = {(int)P_[(st) & 3][0], (int)P_[(st) & 3][1], (int)P_[(st) & 3][2], (int)P_[(st) & 3][3], 0, 0, 0, 0}; \
          const i32x8 bv_ = {(int)Bc[0][0], (int)Bc[0][1], (int)Bc[0][2], (int)Bc[0][3], (int)Bc[1][0], (int)Bc[1][1], (int)Bc[1][2], (int)Bc[1][3]}; \
          acc_ = __builtin_amdgcn_mfma_scale_f32_16x16x128_f8f6f4(av_, bv_, acc_, 4, 0, (st) & 3, (int)S_[(st) >> 2], 0, 0x7f7f7f7f); } \
        __builtin_amdgcn_sched_barrier(0); }
#if DOTS_PROBE
__device__ __forceinline__ float pr_a4(int c) { return c < 2 ? 0.5f * (float)c : (float)(1 << ((c >> 1) - 1)) * (1.0f + 0.5f * (float)(c & 1)); }
__device__ __forceinline__ int pr_fa(int i, int k) { return (i * 3 + k * 5 + (k >> 4)) & 7; }
__device__ __forceinline__ int pr_fb(int k, int j) { return (k * 7 + j * 3 + (k >> 5)) & 7; }
__device__ __forceinline__ int pr_map(int split, int q, int j) { return split ? (j < 16 ? 16 * q + j : 64 + 16 * q + (j - 16)) : 32 * q + j; }
__device__ __forceinline__ void dots_probe(float* res, int lane) {
    const int r = lane & 15, q = lane >> 4;
    const unsigned long long B8 = 0x4E4C4A4844403800ull;
    float ref[4], ref2[4];
#pragma unroll
    for (int t = 0; t < 4; ++t) { float s1 = 0.f, s2 = 0.f; const int i = 4 * q + t;
        for (int k = 0; k < 128; ++k) { const float p = pr_a4(pr_fa(i, k)) * (float)pr_fb(k, r); s1 += p; s2 += p * (float)(1 << ((i + 2 * (k >> 5)) & 3)); }
        ref[t] = s1; ref2[t] = s2; }
    int d = 0;
#pragma unroll 1
    for (int h = 0; h < 4; ++h) { const int sa = h >> 1, sb = h & 1;
        i32x8 av = {0, 0, 0, 0, 0, 0, 0, 0}, bv = {0, 0, 0, 0, 0, 0, 0, 0};
        unsigned aw[4] = {0u, 0u, 0u, 0u}, bw[8] = {0u, 0u, 0u, 0u, 0u, 0u, 0u, 0u};
#pragma unroll
        for (int j = 0; j < 32; ++j) { aw[j >> 3] |= (unsigned)pr_fa(r, pr_map(sa, q, j)) << (4 * (j & 7)); bw[j >> 2] |= (unsigned)((B8 >> (8 * pr_fb(pr_map(sb, q, j), r))) & 0xffull) << (8 * (j & 3)); }
#pragma unroll
        for (int j = 0; j < 4; ++j) av[j] = (int)aw[j];
#pragma unroll
        for (int j = 0; j < 8; ++j) bv[j] = (int)bw[j];
        f32x4 acc = {0.f, 0.f, 0.f, 0.f};
        acc = __builtin_amdgcn_mfma_scale_f32_16x16x128_f8f6f4(av, bv, acc, 4, 0, 0, 0x7f7f7f7f, 0, 0x7f7f7f7f);
        const bool ok = acc[0] == ref[0] && acc[1] == ref[1] && acc[2] == ref[2] && acc[3] == ref[3];
        if (__ballot(ok) == ~0ull && d == 0) d = h + 1;
        if (h == 0) {
            const int sc = ((127 + ((r + 2 * q) & 3)) << 8) | 130 | (131 << 16) | (125 << 24);
            f32x4 a2 = {0.f, 0.f, 0.f, 0.f};
            a2 = __builtin_amdgcn_mfma_scale_f32_16x16x128_f8f6f4(av, bv, a2, 4, 0, 1, sc, 0, 0x7f7f7f7f);
            const bool ok2 = a2[0] == ref2[0] && a2[1] == ref2[1] && a2[2] == ref2[2] && a2[3] == ref2[3];
            if (__ballot(ok2) == ~0ull) d += 5; }
    }
    if (lane == 0) *res = (float)d;
}
#endif
__device__ __forceinline__ void phase_dots(const Args& a, LAS unsigned char* lds, int ctr_set = 0, int tmode = 0) {
#if DOTS_PROBE
    { if (blockIdx.x == 0 && tid_fresh() < 64) dots_probe((float*)(a.ws + WS_DOTS), tid_fresh() & 63); return; }
#endif
    unsigned char* ws = a.ws; const int tid = tid_fresh(), lane = tid & 63, wave = __builtin_amdgcn_readfirstlane(tid >> 6);
    const bf16_t* H2U = (const bf16_t*)(ws + WS_H2U); const int* EIDX = (const int*)(ws + WS_EIDX); const float* RSS = (const float*)(ws + WS_RSS);
    const unsigned char* X8G = ws + WS_X8G; const float* XSCL = (const float*)(ws + WS_XSCL);
    float* DOTS = (float*)(ws + WS_DOTS); unsigned* ctr = (unsigned*)(ws + 32768 + 512 + 512 * ctr_set);
    LAS unsigned char* X8 = lds + wave * DOT_WAVE_LDS;
    LAS unsigned* LIST = (LAS unsigned*)(X8 + 8 * DOT_TS);
    LAS float* SCL = (LAS float*)(X8 + 8 * DOT_TS + 2048);
    const __amdgpu_buffer_rsrc_t rsUT = __builtin_amdgcn_make_buffer_rsrc((void*)(ws + WS_UT), 0, 16 << 20, 0x00020000), rsUS = __builtin_amdgcn_make_buffer_rsrc((void*)(ws + WS_ISU), 0, 1 << 20, 0x00020000),
        rsD = __builtin_amdgcn_make_buffer_rsrc((void*)(ws + WS_DOTS), 0, 16 << 20, 0x00020000);
    i32x4 rsUT4, rsUS4, rsD4;
    { const unsigned long long pu_ = (unsigned long long)(ws + WS_UT), ps_ = (unsigned long long)(ws + WS_ISU), pd_ = (unsigned long long)(ws + WS_DOTS);
      rsUT4 = (i32x4){__builtin_amdgcn_readfirstlane((int)(unsigned)pu_), __builtin_amdgcn_readfirstlane((int)(unsigned)(pu_ >> 32)), 16 << 20, 0x00020000};
      rsUS4 = (i32x4){__builtin_amdgcn_readfirstlane((int)(unsigned)ps_), __builtin_amdgcn_readfirstlane((int)(unsigned)(ps_ >> 32)), 1 << 20, 0x00020000};
      rsD4 = (i32x4){__builtin_amdgcn_readfirstlane((int)(unsigned)pd_), __builtin_amdgcn_readfirstlane((int)(unsigned)(pd_ >> 32)), 16 << 20, 0x00020000}; }
    const int r = lane & 15, q = lane >> 4;
    LAS unsigned char* stw_ = X8 + 18592 + (lane >> 2) * 64 + (((lane & 3) ^ ((lane >> 4) & 3)) * 16);
    const LAS unsigned char* str_ = X8 + 18592 + r * 64 + ((q ^ ((r >> 2) & 3)) * 16);
    const LAS unsigned char* xb_ = X8 + (r & 7) * DOT_TS + q * 16;
#pragma unroll 1
    for (int it = (int)blockIdx.x * NWAVES + wave; it < TOK / 8; it += (int)gridDim.x * NWAVES) {
        {
            const int tok0 = it * 8;
            i32x4 ev[4];
            {   u32x4 xr[8][2];
#pragma unroll
                for (int t = 0; t < 8; ++t) { xr[t][0] = *(const u32x4*)(X8G + (size_t)(tok0 + t) * 2048 + lane * 32); xr[t][1] = *(const u32x4*)(X8G + (size_t)(tok0 + t) * 2048 + lane * 32 + 16); }
                const float xs = XSCL[tok0 + (lane & 7)];
#pragma unroll
                for (int c = 0; c < 4; ++c) ev[c] = *(const i32x4*)(EIDX + (size_t)tok0 * 128 + c * 256 + lane * 4);
#pragma unroll
                for (int t = 0; t < 8; ++t) { *(LAS u32x4*)(X8 + t * DOT_TS + lane * 32) = xr[t][0]; *(LAS u32x4*)(X8 + t * DOT_TS + lane * 32 + 16) = xr[t][1]; }
                if (lane < 8) SCL[lane] = xs;
            }
#pragma unroll 1
          for (int shard = 0; shard < 8; ++shard) {
            int nall = 0;
#pragma unroll
            for (int c = 0; c < 4; ++c)
#pragma unroll
                for (int j = 0; j < 4; ++j) nall += __builtin_popcountll(__ballot((ev[c][j] >> 11) == shard));
            const int nrounds = nall <= 512 ? 1 : 2;
#pragma unroll 1
            for (int rd = 0; rd < nrounds; ++rd) {
                int n = 0;
#pragma unroll
                for (int c = 0; c < 4; ++c) { if (nrounds == 2 && (c >> 1) != rd) continue;
#pragma unroll
                    for (int j = 0; j < 4; ++j) { const int idx = c * 256 + lane * 4 + j; const bool f = (ev[c][j] >> 11) == shard; const unsigned long long m = __ballot(f);
                        if (f) LIST[n + (int)__builtin_amdgcn_mbcnt_hi((unsigned)(m >> 32), __builtin_amdgcn_mbcnt_lo((unsigned)m, 0u))] = (unsigned)(ev[c][j] & 0x3fff) | ((unsigned)(idx >> 7) << 14) | ((unsigned)(idx & 127) << 18);
                        n += __builtin_popcountll(m); } }
                LDS_WAIT();
                const int ng = (tmode & 2) ? 0 : (n + 15) >> 4;
                const float sclv = SCL[r & 7];
                if (ng > 0) {
                    u32x4 A_[16], S_, Sn_ = {0u, 0u, 0u, 0u}; int vo_n;
                    { const unsigned en_ = LIST[r < n ? r : n - 1], en2_ = LIST[(lane >> 2) < n ? (lane >> 2) : n - 1]; const int e_ = (int)(en_ & ((tmode & 4) ? 0x7fu : 0x3fffu)), e2_ = (int)(en2_ & ((tmode & 4) ? 0x7fu : 0x3fffu));
                      vo_n = e2_ * 1024 + (lane & 3) * 16; const int so_ = e_ * 64 + q * 16;
                      DG_SLD(S_, so_);
                      DG_ALD(A_[0], vo_n, 0); DG_ALD(A_[1], vo_n, 64); DG_ALD(A_[2], vo_n, 128); DG_ALD(A_[3], vo_n, 192); DG_ALD(A_[4], vo_n, 256); DG_ALD(A_[5], vo_n, 320); DG_ALD(A_[6], vo_n, 384); DG_ALD(A_[7], vo_n, 448);
                      DG_ALD(A_[8], vo_n, 512); DG_ALD(A_[9], vo_n, 576); DG_ALD(A_[10], vo_n, 640); DG_ALD(A_[11], vo_n, 704); DG_ALD(A_[12], vo_n, 768); DG_ALD(A_[13], vo_n, 832); DG_ALD(A_[14], vo_n, 896); DG_ALD(A_[15], vo_n, 960);
                      { const int m16_ = -16, z_ = 0;
#pragma unroll
                        for (int j = 0; j < 4; ++j) asm volatile("buffer_store_dword %0, %1, %2, 0 offen" :: "v"(z_), "v"(m16_), "s"(rsD4) : "memory"); }
                      asm volatile("s_waitcnt vmcnt(20)" : "+v"(S_) :: "memory"); }
#define DG_GROUP(PF) { f32x4 acc_ = {0.f, 0.f, 0.f, 0.f}; u32x4 b0_[2], b1_[2], b2_[2], b3_[2], P_[4]; \
                    const u32x4 er_ = *(const LAS u32x4*)(LIST + g * 16 + q * 4); DG_BLD(b0_, 0) DG_PERM(0, PF) DG_BLD(b1_, 1) DG_PERM(1, PF) DG_BLD(b2_, 2) __builtin_amdgcn_sched_barrier(0); \
                    DG_STEP(b0_, b3_, 0, PF) DG_STEP(b1_, b0_, 1, PF) DG_STEP(b2_, b1_, 2, PF) DG_STEP(b3_, b2_, 3, PF) DG_STEP(b0_, b3_, 4, PF) DG_STEP(b1_, b0_, 5, PF) DG_STEP(b2_, b1_, 6, PF) DG_STEP(b3_, b2_, 7, PF) \
                    DG_STEP(b0_, b3_, 8, PF) DG_STEP(b1_, b0_, 9, PF) DG_STEP(b2_, b1_, 10, PF) DG_STEP(b3_, b2_, 11, PF) DG_STEP(b0_, b3_, 12, PF) DG_STEP(b1_, b0_, 13, PF) DG_STEP(b2_, b1_, 14, PF) DG_STEP(b3_, b2_, 15, PF) \
                    _Pragma("unroll") for (int j = 0; j < 4; ++j) { const int ri_ = g * 16 + q * 4 + j; const unsigned en_ = er_[j]; const int ts_ = (int)((en_ >> 14) & 15u); \
                        const bool ok_ = ri_ < n && ts_ == r;       \
                        const float val_ = acc_[j] * sclv; const int off_ = (ok_ && tmode == 0) ? (int)((((unsigned)(tok0 + ts_) << 7) + (en_ >> 18)) << 2) : -16; \
                        asm volatile("buffer_store_dword %0, %1, %2, 0 offen" :: "v"(val_), "v"(off_), "s"(rsD4) : "memory"); } }
#pragma unroll 1
                    for (int g = 0; g < ng - 1; ++g) {
                        { const int ix_ = (g + 1) * 16 + r, ix2_ = (g + 1) * 16 + (lane >> 2); const unsigned en_ = LIST[ix_ < n ? ix_ : n - 1], en2_ = LIST[ix2_ < n ? ix2_ : n - 1];
                          const int e_ = (int)(en_ & ((tmode & 4) ? 0x7fu : 0x3fffu)), e2_ = (int)(en2_ & ((tmode & 4) ? 0x7fu : 0x3fffu)); vo_n = e2_ * 1024 + (lane & 3) * 16; const int so_ = e_ * 64 + q * 16;
                          DG_SLD(Sn_, so_); }
                        DG_GROUP(true)
                        asm volatile("s_waitcnt vmcnt(20)" : "+v"(Sn_) :: "memory");
                        S_ = Sn_;
                    }
                    { const int g = ng - 1; DG_GROUP(false) }
#undef DG_GROUP
                }
                LDS_WAIT();
            }
          }
        }
    }
}
#undef DG_STEP
#undef DG_PERM
#undef DG_BLD
#undef DG_ALD
#undef DG_SLD

constexpr int N_PHASES = 13;
template <int LO, int HI> __global__ void __launch_bounds__(NTHREADS, 2) fwd_kernel(Args a_in) {
    extern __shared__ __attribute__((aligned(16))) unsigned char lds_raw[];
    LAS unsigned char* lds = (LAS unsigned char*)lds_raw;
    const int G = gridDim.x;
#if defined(__HIP_DEVICE_COMPILE__)
    typedef const __attribute__((address_space(4))) Args* KArgsPtr;
    KArgsPtr kap = (KArgsPtr)__builtin_amdgcn_kernarg_segment_ptr();
#define PHASE_ARGS() KArgsPtr kp_ = kap; asm volatile("" : "+s"(kp_)); const Args a = *kp_; unsigned char* ws = a.ws; (void)ws
#else
#define PHASE_ARGS() const Args a = a_in; unsigned char* ws = a.ws; (void)ws
#endif
#define IN(k) (LO <= (k) && (k) < HI)
    XcdBarrier xbar; xbar.bar = nullptr; xbar.x = 0; xbar.st = nullptr;
    if constexpr (HI - LO > 1) {
        volatile LAS unsigned* misc = (volatile LAS unsigned*)(lds + LDS_BYTES - 256);
        if (threadIdx.x < 2) misc[threadIdx.x] = 0u;
        __syncthreads();
        xbar = xcd_barrier_post((unsigned*)(a_in.ws) + 1024, misc);
    }
#define SEAM(k) do { if constexpr (IN(k) && IN((k) + 1)) { xcd_barrier(xbar); } } while (0)
    if constexpr (IN(0)) { PHASE_ARGS(); phase0(a, lds); } SEAM(0);
    if constexpr (IN(1)) { PHASE_ARGS();
        pg::Desc d{}; pg::desc_seg(d, 0, ws + WS_HA8, 1024, 0, ws + WS_WG8, 1024, 0, 1024); d.nt[1] = 0; d.toep = 0;
        pg::StaticOrder S; S.init(MROWS, IN_COLS, G, (int)blockIdx.x);
        EpiG1 E{ws, a.b_gate};
        pg::gemm_phase<EpiG1, pg::StaticOrder, false, true>(lds, d, S, E);
    } SEAM(1);
    if constexpr (IN(2)) { PHASE_ARGS();
        pg::Desc d{}; pg::desc_seg(d, 0, ws + WS_AG, LDA_G, (long)NCHUNK * LDA_G * 2, ws + WS_PT, 1024, (long)256 * 1024 * 2, 1024); d.nt[1] = 0; d.toep = 0;
        pg::GroupOrder S{2, 1, 64, G, (int)blockIdx.x};
        EpiG2 E{(float*)(ws + WS_S)};
        pg::gemm_phase<EpiG2, pg::GroupOrder, false>(lds, d, S, E);
        if ((int)blockIdx.x < 128 && G >= 128) {
            asm volatile("s_waitcnt vmcnt(0)" ::: "memory"); __syncthreads();
            __builtin_amdgcn_fence(__ATOMIC_ACQUIRE, "agent"); asm volatile("s_waitcnt vmcnt(0)" ::: "memory");
            scan_unit(a, (int)blockIdx.x >> 1, (int)blockIdx.x & 1);
        } else if (G < 128) { for (int L = blockIdx.x; L < 128; L += G) { asm volatile("s_waitcnt vmcnt(0)" ::: "memory"); __syncthreads(); __builtin_amdgcn_fence(__ATOMIC_ACQUIRE, "agent"); asm volatile("s_waitcnt vmcnt(0)" ::: "memory"); scan_unit(a, L >> 1, L & 1); } }
        phase_attn(a, lds);
    } SEAM(2);
    if constexpr (IN(4)) { PHASE_ARGS();
        pg::Desc d{}; pg::desc_seg(d, 0, ws + WS_AG, LDA_G, (long)NCHUNK * LDA_G * 2, ws + WS_KTAB + (63 * 256 - 768) * 2, 0, (long)128 * 256 * 2, 1024);
        d.kB[0] = -2048; d.hB[0] = 4096; d.tB[0] = 8192; d.toep = 1;
        pg::desc_seg(d, 1, ws + WS_AG + 1024 * 2, LDA_G, (long)NCHUNK * LDA_G * 2, ws + WS_QT, 256, (long)1024 * 256 * 2, 256);
        pg::GroupOrder S{2, 4, 64, G, (int)blockIdx.x};
        EpiG3 E{(const bf16_t*)(ws + WS_AG), a.ssm_d, (bf16_t*)(ws + WS_YAPRE)};
        pg::gemm_phase<EpiG3, pg::GroupOrder, true>(lds, d, S, E);
    } SEAM(4);
    if constexpr (IN(5)) { PHASE_ARGS();
        pg::Desc d{}; pg::desc_seg(d, 0, ws + WS_YAPRE, 1024, 0, ws + WS_WGLU, 1024, 0, 1024); d.nt[1] = 0; d.toep = 0;
        pg::StaticOrder S; S.init(TOK, 1024, G, (int)blockIdx.x);
        EpiBf<0> E{(bf16_t*)(ws + WS_YA8), 1024, (const bf16_t*)(ws + WS_YAPRE), 1024, nullptr, a.b_glu, nullptr};
        pg::gemm_phase<EpiBf<0>, pg::StaticOrder, false>(lds, d, S, E);
    } SEAM(5);
    if constexpr (IN(6)) { PHASE_ARGS();
        pg::Desc d{}; pg::desc_seg(d, 0, ws + WS_YA8, 512, 0, ws + WS_WP8, 512, 0, 512); d.nt[1] = 0; d.toep = 0;
        pg::StaticOrder S; S.init(TOK, 2048, G, (int)blockIdx.x);
        EpiBf<1> E{(bf16_t*)(ws + WS_M0), 2048, nullptr, 0, (const bf16_t*)(ws + WS_GATES), nullptr, nullptr};
        pg::gemm_phase<EpiBf<1>, pg::StaticOrder, false, true>(lds, d, S, E);
    }
    if constexpr (IN(7)) { PHASE_ARGS();
        pg::Desc d{}; pg::desc_seg(d, 0, ws + WS_YB8, 512, 0, ws + WS_WP8 + 2048 * 1024, 512, 0, 512); d.nt[1] = 0; d.toep = 0;
        pg::StaticOrder S; S.init(TOK, 2048, G, (int)blockIdx.x);
        EpiBf<2> E{(bf16_t*)(ws + WS_MERGED), 2048, (const bf16_t*)(ws + WS_M0), 2048, (const bf16_t*)(ws + WS_GATES), nullptr, nullptr};
        pg::gemm_phase<EpiBf<2>, pg::StaticOrder, false, true>(lds, d, S, E);
    } SEAM(7);
    if constexpr (IN(8)) { PHASE_ARGS();
        pg::Desc d{}; pg::desc_seg(d, 0, ws + WS_MERGED, 1024, 0, ws + WS_WOUT, 1024, 0, 1024); d.nt[1] = 0; d.toep = 0;
        pg::StaticOrder S; S.init(TOK, 2048, G, (int)blockIdx.x);
        EpiG6 E{a.x, (bf16_t*)(ws + WS_H2U), (float*)(ws + WS_RSS)};
        pg::gemm_phase<EpiG6, pg::StaticOrder, false, true>(lds, d, S, E);
    } SEAM(8);
    if constexpr (IN(9)) { PHASE_ARGS();
        pg::Desc d{}; pg::desc_seg(d, 0, ws + WS_H2U, 2048, 0, ws + WS_WQ, 2048, 0, 2048); d.nt[1] = 0; d.toep = 0;
        pg::StaticOrder S; S.init(TOK, 2048, G, (int)blockIdx.x);
        EpiBf<3> E{(bf16_t*)(ws + WS_QP), 2048, nullptr, 0, nullptr, nullptr, (const float*)(ws + WS_RSS)};
        pg::gemm_phase<EpiBf<3>, pg::StaticOrder, false>(lds, d, S, E);
        asm volatile("s_waitcnt vmcnt(0)" ::: "memory"); __syncthreads(); __builtin_amdgcn_fence(__ATOMIC_ACQUIRE, "agent"); asm volatile("s_waitcnt vmcnt(0)" ::: "memory");
    }
    if constexpr (IN(10)) { PHASE_ARGS(); phase_topk(a, lds); if (MFMA_A) phase_x8(a); } SEAM(10);
    if constexpr (IN(11)) { PHASE_ARGS(); if (MFMA_A) phase_dots(a, lds);
#if TIME_DOTS
        xcd_barrier(xbar); phase_dots(a, lds, 1, TIME_DOTS);
#endif
        asm volatile("s_waitcnt vmcnt(0)" ::: "memory"); __builtin_amdgcn_fence(__ATOMIC_ACQUIRE, "agent"); asm volatile("s_waitcnt vmcnt(0)" ::: "memory");
    }
    if constexpr (IN(12)) { PHASE_ARGS(); phase_gather(a); }
#undef IN
#undef SEAM
}

#if MK_N_LAUNCHES == 1
constexpr int NK = 1;
static const void* kfun(int) { return (const void*)fwd_kernel<0, N_PHASES>; }
#else
constexpr int NK = N_PHASES;
static const void* kfun(int p) {
    switch (p) { case 0: return (const void*)fwd_kernel<0, 1>; case 1: return (const void*)fwd_kernel<1, 2>; case 2: return (const void*)fwd_kernel<2, 3>; case 3: return (const void*)fwd_kernel<3, 4>;
        case 4: return (const void*)fwd_kernel<4, 5>; case 5: return (const void*)fwd_kernel<5, 6>; case 6: return (const void*)fwd_kernel<6, 7>; case 7: return (const void*)fwd_kernel<7, 8>;
        case 8: return (const void*)fwd_kernel<8, 9>; case 9: return (const void*)fwd_kernel<9, 10>; case 10: return (const void*)fwd_kernel<10, 11>; case 11: return (const void*)fwd_kernel<11, 12>; default: return (const void*)fwd_kernel<12, 13>; }
}
#endif
extern "C" void kernel_launch(void* const* d_in, const int* in_sizes, int n_in, void* d_out, int out_size, void* d_ws, size_t ws_size, hipStream_t stream) {
    static int grid = 0;
    if (grid == 0) {
        if (n_in != 26 || out_size != TOK * D_MODEL || ws_size < WS_END) { fprintf(stderr, "kernel_launch: unexpected shapes n_in %d out %d ws %zu\n", n_in, out_size, ws_size); grid = -1; return; }
        int dev = 0, cus = 0, per_cu = 0;
        if (hipGetDevice(&dev) != hipSuccess || hipDeviceGetAttribute(&cus, hipDeviceAttributeMultiprocessorCount, dev) != hipSuccess) { grid = -1; return; }
        for (int p = 0; p < NK; ++p) if (hipFuncSetAttribute(kfun(p), hipFuncAttributeMaxDynamicSharedMemorySize, LDS_BYTES) != hipSuccess) { fprintf(stderr, "kernel_launch: hipFuncSetAttribute failed\n"); grid = -1; return; }
        if (hipOccupancyMaxActiveBlocksPerMultiprocessor(&per_cu, kfun(0), NTHREADS, LDS_BYTES) != hipSuccess || per_cu < 1) { fprintf(stderr, "kernel_launch: occupancy query says %d\n", per_cu); per_cu = 1; }
        (void)hipGetLastError();
        grid = cus;
        fprintf(stderr, "kernel_launch: cus %d per_cu %d grid %d ws %zu\n", cus, per_cu, grid, ws_size);
    }
    if (grid < 0) return;
    Args a{};
    const float* const* in = (const float* const*)d_in;
    a.x = in[0]; a.meta = in[1]; a.norm_mix = in[2]; a.w_in = in[3]; a.b_gate = in[4]; a.lam_re = in[5]; a.lam_im = in[6]; a.log_dt = in[7];
    a.b_re = in[8]; a.b_im = in[9]; a.c_re = in[10]; a.c_im = in[11]; a.ssm_d = in[12]; a.w_glu = in[13]; a.b_glu = in[14]; a.sink = in[15];
    a.w_ps = in[16]; a.w_pa = in[17]; a.w_out = in[18]; a.norm_ffn = in[19]; a.w_q = in[20]; a.pk1 = in[21]; a.pk2 = in[22]; a.pu = in[23]; a.pv = in[24]; a.norm_final = in[25];
    a.out = (float*)d_out; a.ws = (unsigned char*)d_ws;
#if MK_N_LAUNCHES == 1
    a.ph_lo = 0; a.ph_hi = N_PHASES;
    if (hipMemsetAsync(d_ws, 0, 65536, stream) != hipSuccess) { fprintf(stderr, "kernel_launch: memset of the barrier words failed\n"); return; }
    void* args[] = {&a};
    hipError_t e = hipLaunchCooperativeKernel(kfun(0), dim3(grid), dim3(NTHREADS), args, LDS_BYTES, stream);
    if (e != hipSuccess) fprintf(stderr, "kernel_launch: cooperative launch failed: %s\n", hipGetErrorString(e));
#else
    (void)hipMemsetAsync(d_ws, 0, 65536, stream);
    for (int p = 0; p < N_PHASES; ++p) { a.ph_lo = p; a.ph_hi = p + 1; void* args[] = {&a};
        hipError_t e = hipLaunchKernel(kfun(p), dim3(grid), dim3(NTHREADS), args, LDS_BYTES, stream);
        if (e != hipSuccess) fprintf(stderr, "kernel_launch: launch %d failed: %s\n", p, hipGetErrorString(e));
        if ((REP_MASK >> p) & 1) (void)hipLaunchKernel(kfun(p), dim3(grid), dim3(NTHREADS), args, LDS_BYTES, stream); }
#endif
}
```

```cpp
#include <hip/hip_runtime.h>
#include <hip/hip_cooperative_groups.h>
#include <cstdio>
#include <cstdint>
namespace cg = cooperative_groups;

#ifndef DBG
#define DBG 0
#endif
#ifndef REP_MASK
#define REP_MASK 0
#endif
#ifndef MK_N_LAUNCHES
#define MK_N_LAUNCHES 1
#endif

#define LAS __attribute__((address_space(3)))
typedef unsigned short bf16_t;
typedef short bf16x8 __attribute__((ext_vector_type(8)));
typedef short s16x4 __attribute__((ext_vector_type(4)));
typedef float f32x4 __attribute__((ext_vector_type(4)));
typedef float f32x2 __attribute__((ext_vector_type(2)));
typedef float f32x16 __attribute__((ext_vector_type(16)));
typedef unsigned u32x4 __attribute__((ext_vector_type(4)));
typedef unsigned u32x2 __attribute__((ext_vector_type(2)));
typedef unsigned u32x6 __attribute__((ext_vector_type(6)));
typedef float f32x32 __attribute__((ext_vector_type(32)));
typedef int i32x8 __attribute__((ext_vector_type(8)));
typedef int i32x4 __attribute__((ext_vector_type(4)));

constexpr int D_MODEL = 2048, BATCH = 4, SEQ = 8192, N_META = 16;
constexpr int TOK = BATCH * SEQ;
constexpr int MROWS = TOK + 256;
constexpr int IN_COLS = 6656;
constexpr int NCHUNK = TOK / 64;
constexpr int LDA_G = 1280;
constexpr float NORM_EPS = 1e-6f;
constexpr float LOG2E = 1.4426950408889634f;
constexpr int NTHREADS = 512, NWAVES = 8;
constexpr int LDS_BYTES = 163840;

constexpr size_t MiB = 1u << 20;
constexpr size_t WS_WIN = 1 * MiB;
constexpr size_t WS_DOTS = 1 * MiB;
constexpr size_t WS_WGLU = 27 * MiB;
constexpr size_t WS_WPS = 29 * MiB;
constexpr size_t WS_WPA = 33 * MiB;
constexpr size_t WS_WOUT = 37 * MiB;
constexpr size_t WS_WQ = 45 * MiB;
constexpr size_t WS_PK = 53 * MiB;
constexpr size_t WS_S5M = 54 * MiB;
constexpr size_t WS_UMETA = 55 * MiB + 512 * 1024;

constexpr size_t WS_UT = 56 * MiB;
constexpr size_t WS_VT = 80 * MiB;
constexpr size_t WS_ISU = 96 * MiB;
constexpr size_t WS_ISV = 97 * MiB;
constexpr size_t WS_HA8 = 100 * MiB;
constexpr size_t WS_YB8 = 100 * MiB;
constexpr size_t WS_YA8 = 132 * MiB;
constexpr size_t WS_WP8 = 179 * MiB;
constexpr size_t WS_WG8 = 166 * MiB;
constexpr size_t WS_KTAB = 184 * MiB;
constexpr size_t WS_PT = 188 * MiB;
constexpr size_t WS_QT = 220 * MiB;
constexpr size_t WS_GATES = 252 * MiB;
constexpr size_t WS_QP = 252 * MiB;
constexpr size_t WS_EIDX = 380 * MiB;
constexpr size_t WS_EGATE = 396 * MiB;
constexpr size_t WS_HA = 508 * MiB;
constexpr size_t WS_M0 = 508 * MiB;
constexpr size_t WS_H2U = 508 * MiB;
constexpr size_t WS_AG = 638 * MiB;
constexpr size_t WS_YA = 638 * MiB;
constexpr size_t WS_MERGED = 638 * MiB;
constexpr size_t WS_X8G = 638 * MiB;
constexpr size_t WS_XSCL = 702 * MiB;
constexpr size_t WS_Q = 718 * MiB;
constexpr size_t WS_K = 782 * MiB;
constexpr size_t WS_V = 799 * MiB;
constexpr size_t WS_S = 816 * MiB;
constexpr size_t WS_YAPRE = 848 * MiB;
constexpr size_t WS_YB = 912 * MiB;
constexpr size_t WS_RSS = 976 * MiB;
constexpr size_t WS_END = 980 * MiB;

__device__ __forceinline__ unsigned cvt_pk_bf16(float lo, float hi) { unsigned r; asm volatile("s_nop 0\n\tv_cvt_pk_bf16_f32 %0, %1, %2" : "=v"(r) : "v"(lo), "v"(hi)); return r; }
__device__ __forceinline__ float bf_lo(unsigned u) { return __uint_as_float(u << 16); }
__device__ __forceinline__ float bf_hi(unsigned u) { return __uint_as_float(u & 0xffff0000u); }
__device__ __forceinline__ float wave_sum(float v) {
#pragma unroll
    for (int o = 1; o < 64; o <<= 1) v += __shfl_xor(v, o);
    return v;
}
__device__ __forceinline__ float sigmoidf_(float z) { return __builtin_amdgcn_rcpf(1.0f + __builtin_amdgcn_exp2f(-z * LOG2E)); }
__device__ __forceinline__ float gelu_tanh(float x) {
    const float z = x * (1.0f + 0.044715f * x * x);
    return x * __builtin_amdgcn_rcpf(1.0f + __builtin_amdgcn_exp2f(-2.0f * 0.7978845608028654f * LOG2E * z));
}
__device__ __forceinline__ int tid_fresh() { int t = threadIdx.x; asm volatile("" : "+v"(t)); return t; }
#define LDS_WAIT() asm volatile("s_waitcnt lgkmcnt(0)" ::: "memory")
#define VM_WAIT() asm volatile("s_waitcnt vmcnt(0)" ::: "memory")

namespace pg {
constexpr int BM = 256, BK = 64, HALF = 128, HTB = HALF * BK * 2, NXCD = 8, WGM = 8;
__host__ __device__ __forceinline__ int lds_byte(int r, int c) { const int st = (r >> 4) * 2 + (c >> 5), rr = r & 15, cc = c & 31, ob = rr * 64 + cc * 2; return st * 1024 + (ob ^ (((ob >> 9) & 1) << 5)); }
__host__ __device__ __forceinline__ void stage_rc(int b, int& R, int& C) { const int st = b / 1024, sb = b % 1024, swz = sb ^ (((sb >> 9) & 1) << 5); R = (st >> 1) * 16 + swz / 64; C = (st & 1) * 32 + (swz % 64) / 2; }
__host__ __device__ __forceinline__ int perm32(int rho) { const int n = rho >> 4, i = rho & 15; return 8 * (i >> 2) + 4 * n + (i & 3); }

struct Unit { int pm, pn, grp; };
struct Desc {
    const char* A[2]; const char* B[2];
    long kA[2], kB[2];
    long hA[2], hB[2];
    long tA[2], tB[2];
    long gA[2], gB[2];
    int lda[2], ldb[2];
    int nt[2];
    int toep;
};
__host__ __device__ inline void desc_seg(Desc& d, int s, const void* A, int lda, long gA, const void* B, int ldb, long gB, int K) {
    d.A[s] = (const char*)A; d.B[s] = (const char*)B; d.lda[s] = lda; d.ldb[s] = ldb;
    d.kA[s] = BK * 2; d.kB[s] = BK * 2; d.hA[s] = (long)HALF * lda * 2; d.hB[s] = (long)HALF * ldb * 2; d.tA[s] = 2 * d.hA[s]; d.tB[s] = 2 * d.hB[s];
    d.gA[s] = gA; d.gB[s] = gB; d.nt[s] = K / BK;
}
struct StaticOrder {
    int nM, nN, nwg, G, c;
    __device__ void init(int M, int N, int G_, int c_) { nM = M / BM; nN = N / BM; nwg = nM * nN; G = G_; c = c_; }
    __device__ bool next(int i, Unit& u) const {
        const long L = (long)i * G + c; if (L >= nwg) return false;
        int wgid = (int)L; { const int q = nwg / NXCD, r = nwg % NXCD, xcd = wgid % NXCD, off = wgid / NXCD; wgid = (xcd < r ? xcd * (q + 1) : r * (q + 1) + (xcd - r) * q) + off; }
        const int nig = WGM * nN, gid = wgid / nig, fm = gid * WGM, gsz = (nM - fm) < WGM ? (nM - fm) : WGM;
        u.pm = fm + ((wgid % nig) % gsz); u.pn = (wgid % nig) / gsz; u.grp = 0; return true;
    }
};
struct GroupOrder {
    int nM, nN, ng, G, c;
    __device__ bool next(int i, Unit& u) const {
        const long L = (long)i * G + c; if (L >= (long)ng * nM * nN) return false;
        const int per = nM * nN; u.grp = (int)(L / per); const int r = (int)(L % per); u.pm = r / nN; u.pn = r % nN; return true;
    }
};

#define PG_SA(b, h) (((b) * 2 + (h)) * HTB)
#define PG_SB(b, h) ((4 + (b) * 2 + (h)) * HTB)
#define PG_STAGE(bufoff, gbase, v0, v1) do { \
        __builtin_amdgcn_global_load_lds((const unsigned*)((const char*)(gbase) + (v0)), (LAS unsigned*)(lds + (bufoff) + ldsw), 16, 0, 0); \
        __builtin_amdgcn_global_load_lds((const unsigned*)((const char*)(gbase) + (v1)), (LAS unsigned*)(lds + (bufoff) + ldsw + 8192), 16, 0, 0); } while (0)
typedef int v4i32_ __attribute__((ext_vector_type(4)));
#define PG_LD8(p) ({ const v4i32_ lo_ = *(const LAS v4i32_*)(p), hi_ = *(const LAS v4i32_*)((p) + 1024); __builtin_shufflevector(lo_, hi_, 0, 1, 2, 3, 4, 5, 6, 7); })
#define PG_LDA(dst, b, h) do { if constexpr (FP8) { _Pragma("unroll") for (int m = 0; m < 4; ++m) dst##8[m] = PG_LD8(lds + PG_SA(b, h) + aoff + m * 2048); } \
        else { _Pragma("unroll") for (int m = 0; m < 4; ++m) _Pragma("unroll") for (int k = 0; k < 2; ++k) dst[m][k] = *(const LAS bf16x8*)(lds + PG_SA(b, h) + aoff + m * 2048 + k * 1024); } } while (0)
#define PG_LDB(dst, b, h) do { if constexpr (FP8) { _Pragma("unroll") for (int n = 0; n < 2; ++n) dst##8[n] = PG_LD8(lds + PG_SB(b, h) + boff + n * 2048); } \
        else { _Pragma("unroll") for (int n = 0; n < 2; ++n) _Pragma("unroll") for (int k = 0; k < 2; ++k) dst[n][k] = *(const LAS bf16x8*)(lds + PG_SB(b, h) + boff + n * 2048 + k * 1024); } } while (0)
typedef int v8i32 __attribute__((ext_vector_type(8)));
#define PG_MMA(ai, bj, At, Bt) do { __builtin_amdgcn_s_setprio(1); \
        if constexpr (FP8) { _Pragma("unroll") for (int m = 0; m < 4; ++m) _Pragma("unroll") for (int n = 0; n < 2; ++n) \
            asm volatile("v_mfma_f32_16x16x128_f8f6f4 %0, %1, %2, %0" : "+v"(acc[ai][bj][m][n]) : "v"(Bt##8[n]), "v"(At##8[m])); } \
        else { _Pragma("unroll") for (int m = 0; m < 4; ++m) _Pragma("unroll") for (int n = 0; n < 2; ++n) _Pragma("unroll") for (int k = 0; k < 2; ++k) \
            acc[ai][bj][m][n] = __builtin_amdgcn_mfma_f32_16x16x32_bf16(Bt[n][k], At[m][k], acc[ai][bj][m][n], 0, 0, 0); } \
        __builtin_amdgcn_s_setprio(0); } while (0)
#define PG_WAIT_V(n) asm volatile("s_waitcnt vmcnt(" #n ")" ::: "memory")
#define PG_WAIT_L(n) asm volatile("s_waitcnt lgkmcnt(" #n ")" ::: "memory")
#define PG_BAR __builtin_amdgcn_s_barrier()
#define PG_SCHED __builtin_amdgcn_sched_barrier(0)

template <class Epi, class Order, bool TWO, bool FP8 = false>
__device__ __forceinline__ void gemm_phase(LAS unsigned char* lds, const Desc g, const Order& S, const Epi& E) {
    const int tid = tid_fresh(), wid = __builtin_amdgcn_readfirstlane(tid >> 6), lane = tid & 63, wr = wid >> 2, wc = wid & 3, fr = lane & 15, fq = lane >> 4;
    const int nt0 = g.nt[0], nt = nt0 + (TWO ? g.nt[1] : 0);
    unsigned voffA[2][2], voffB[2][2];
#pragma unroll
    for (int s = 0; s < (TWO ? 2 : 1); ++s)
#pragma unroll
        for (int i = 0; i < 2; ++i) { int R, C; stage_rc(tid * 16 + i * 8192, R, C); const int Rb = Epi::PERM ? ((R & ~31) + perm32(R & 31)) : R;
            voffA[s][i] = (unsigned)(R * g.lda[s] + C) * 2u;
            voffB[s][i] = (s == 0 && g.toep) ? (unsigned)(16 * Rb - 16 * C + 17 * (C & 15) + 768) * 2u : (unsigned)(Rb * g.ldb[s] + C) * 2u; }
    const unsigned ldsw = (unsigned)wid * 1024u;
    const int aoff = lds_byte(wr * 64 + fr, fq * 8), boff = lds_byte(wc * 32 + fr, fq * 8);
    Unit cur, nxt; int ui = 0;
    if (!S.next(0, cur)) return;
    f32x4 acc[2][2][4][2];
    bf16x8 At[4][2], B0[2][2], B1[2][2]; v8i32 At8[4], B08[2], B18[2]; (void)At; (void)B0; (void)B1; (void)At8; (void)B08; (void)B18;
    const char* cA0 = g.A[0] + (long)cur.pm * g.tA[0] + (long)cur.grp * g.gA[0];
    const char* cB0 = g.B[0] + (long)cur.pn * g.tB[0] + (long)cur.grp * g.gB[0];
    const char* cA1 = TWO ? g.A[1] + (long)cur.pm * g.tA[1] + (long)cur.grp * g.gA[1] : cA0;
    const char* cB1 = TWO ? g.B[1] + (long)cur.pn * g.tB[1] + (long)cur.grp * g.gB[1] : cB0;
    PG_STAGE(PG_SB(0, 0), cB0, voffB[0][0], voffB[0][1]); PG_STAGE(PG_SB(0, 1), cB0 + g.hB[0], voffB[0][0], voffB[0][1]);
    PG_STAGE(PG_SA(0, 0), cA0, voffA[0][0], voffA[0][1]); PG_STAGE(PG_SA(0, 1), cA0 + g.hA[0], voffA[0][0], voffA[0][1]);
    if (wr == 1) PG_BAR;
    PG_WAIT_V(2); PG_BAR;
    PG_STAGE(PG_SB(1, 0), cB0 + g.kB[0], voffB[0][0], voffB[0][1]); PG_STAGE(PG_SA(1, 0), cA0 + g.kA[0], voffA[0][0], voffA[0][1]); PG_STAGE(PG_SB(1, 1), cB0 + g.hB[0] + g.kB[0], voffB[0][0], voffB[0][1]);
    PG_WAIT_V(6); PG_BAR;
    __builtin_amdgcn_sched_barrier(0);
#pragma unroll
    for (int a = 0; a < 2; ++a)
#pragma unroll
        for (int b = 0; b < 2; ++b)
#pragma unroll
            for (int m = 0; m < 4; ++m)
#pragma unroll
                for (int n = 0; n < 2; ++n) acc[a][b][m][n] = (f32x4){0.f, 0.f, 0.f, 0.f};
    for (;;) {
        const bool has_next = S.next(ui + 1, nxt);
        const char* nA0 = has_next ? g.A[0] + (long)nxt.pm * g.tA[0] + (long)nxt.grp * g.gA[0] : cA0;
        const char* nB0 = has_next ? g.B[0] + (long)nxt.pn * g.tB[0] + (long)nxt.grp * g.gB[0] : cB0;
        for (int t = 0; t < nt; t += 2) {
            const bool last = (t == nt - 2);
            const int sc = (TWO && t >= nt0) ? 1 : 0, tl = t - (sc ? nt0 : 0);
            const char* a1 = (sc ? cA1 : cA0) + (long)(tl + 1) * (sc ? g.kA[1] : g.kA[0]);
            const long hA1 = sc ? g.hA[1] : g.hA[0];
            const unsigned va1_0 = sc ? voffA[1][0] : voffA[0][0], va1_1 = sc ? voffA[1][1] : voffA[0][1];
            int sn = 0; const char* a2; const char* b2;
            if (last) { a2 = nA0; b2 = nB0; }
            else { const int t2 = t + 2; sn = (TWO && t2 >= nt0) ? 1 : 0; const int tl2 = t2 - (sn ? nt0 : 0); a2 = (sn ? cA1 : cA0) + (long)tl2 * (sn ? g.kA[1] : g.kA[0]); b2 = (sn ? cB1 : cB0) + (long)tl2 * (sn ? g.kB[1] : g.kB[0]); }
            const char* a3 = a2 + (sn ? g.kA[1] : g.kA[0]); const char* b3 = b2 + (sn ? g.kB[1] : g.kB[0]);
            const long hA2 = sn ? g.hA[1] : g.hA[0], hB2 = sn ? g.hB[1] : g.hB[0];
            const unsigned va2_0 = sn ? voffA[1][0] : voffA[0][0], va2_1 = sn ? voffA[1][1] : voffA[0][1];
            const unsigned vb2_0 = sn ? voffB[1][0] : voffB[0][0], vb2_1 = sn ? voffB[1][1] : voffB[0][1];
            PG_LDB(B0, 0, 0); PG_LDB(B1, 0, 1); PG_SCHED; PG_LDA(At, 0, 0); PG_STAGE(PG_SA(1, 1), a1 + hA1, va1_0, va1_1);
            PG_WAIT_V(8); PG_WAIT_L(0); PG_BAR; PG_MMA(0, 0, At, B0); PG_MMA(0, 1, At, B1); PG_BAR; PG_SCHED;
            PG_LDA(At, 0, 1); PG_STAGE(PG_SB(0, 0), b2, vb2_0, vb2_1); PG_STAGE(PG_SB(0, 1), b2 + hB2, vb2_0, vb2_1); PG_STAGE(PG_SA(0, 0), a2, va2_0, va2_1);
            PG_WAIT_V(8); PG_WAIT_L(0); PG_BAR; PG_MMA(1, 0, At, B0); PG_MMA(1, 1, At, B1); PG_BAR; PG_SCHED;
            PG_LDB(B0, 1, 0); PG_LDB(B1, 1, 1); PG_SCHED; PG_LDA(At, 1, 0); PG_STAGE(PG_SA(0, 1), a2 + hA2, va2_0, va2_1);
            PG_WAIT_V(8); PG_WAIT_L(0); PG_BAR; PG_MMA(0, 0, At, B0); PG_MMA(0, 1, At, B1); PG_BAR; PG_SCHED;
            PG_LDA(At, 1, 1); PG_STAGE(PG_SB(1, 0), b3, vb2_0, vb2_1); PG_STAGE(PG_SB(1, 1), b3 + hB2, vb2_0, vb2_1); PG_STAGE(PG_SA(1, 0), a3, va2_0, va2_1);
            PG_WAIT_V(8); PG_WAIT_L(0); PG_BAR; PG_MMA(1, 0, At, B0); PG_MMA(1, 1, At, B1); PG_BAR; PG_SCHED;
        }
        if (wr == 0) PG_BAR;
        if constexpr (FP8) {
#pragma unroll
            for (int a = 0; a < 2; ++a)
#pragma unroll
                for (int b = 0; b < 2; ++b)
                    asm volatile("s_nop 15\n\ts_nop 15" : "+v"(acc[a][b][0][0]), "+v"(acc[a][b][0][1]), "+v"(acc[a][b][1][0]), "+v"(acc[a][b][1][1]),
                                 "+v"(acc[a][b][2][0]), "+v"(acc[a][b][2][1]), "+v"(acc[a][b][3][0]), "+v"(acc[a][b][3][1]) :: "memory"); }
        E(acc, cur, wr, wc, fr, fq);
        if (!has_next) break;
#pragma unroll
        for (int a = 0; a < 2; ++a)
#pragma unroll
            for (int b = 0; b < 2; ++b)
#pragma unroll
                for (int m = 0; m < 4; ++m)
#pragma unroll
                    for (int n = 0; n < 2; ++n) acc[a][b][m][n] = (f32x4){0.f, 0.f, 0.f, 0.f};
        cur = nxt; cA0 = nA0; cB0 = nB0; ++ui;
        if (TWO) { cA1 = g.A[1] + (long)cur.pm * g.tA[1] + (long)cur.grp * g.gA[1]; cB1 = g.B[1] + (long)cur.pn * g.tB[1] + (long)cur.grp * g.gB[1]; }
        if (wr == 1) PG_BAR;
    }
    PG_WAIT_V(0);
    PG_BAR;
}
}

#define EPI_LOOP_BEGIN \
    _Pragma("unroll") for (int ai = 0; ai < 2; ++ai) _Pragma("unroll") for (int m = 0; m < 4; ++m) { const int row = u.pm * 256 + ai * 128 + wr * 64 + m * 16 + fr; \
    _Pragma("unroll") for (int bj = 0; bj < 2; ++bj) {
#define EPI_LOOP_END } }
#define EPI_BATCH_BEGIN(ai0, ai1) \
    _Pragma("unroll") for (int ai = (ai0); ai < (ai1); ++ai) _Pragma("unroll") for (int m = 0; m < 4; ++m) { const int row = u.pm * 256 + ai * 128 + wr * 64 + m * 16 + fr; \
    _Pragma("unroll") for (int bj = 0; bj < 2; ++bj) { const int ck = ((ai - (ai0)) * 4 + m) * 2 + bj; (void)ck; (void)row;
#define EPI_BATCH_END } }

__device__ __forceinline__ u32x2 gates_pack8(const f32x4 v0, const f32x4 v1) {
    unsigned a = 0u, b = 0u;
    a = __builtin_amdgcn_cvt_pk_u8_f32(v0[0] * 255.0f, 0, a); a = __builtin_amdgcn_cvt_pk_u8_f32(v0[1] * 255.0f, 1, a); a = __builtin_amdgcn_cvt_pk_u8_f32(v0[2] * 255.0f, 2, a); a = __builtin_amdgcn_cvt_pk_u8_f32(v0[3] * 255.0f, 3, a);
    b = __builtin_amdgcn_cvt_pk_u8_f32(v1[0] * 255.0f, 0, b); b = __builtin_amdgcn_cvt_pk_u8_f32(v1[1] * 255.0f, 1, b); b = __builtin_amdgcn_cvt_pk_u8_f32(v1[2] * 255.0f, 2, b); b = __builtin_amdgcn_cvt_pk_u8_f32(v1[3] * 255.0f, 3, b);
    return (u32x2){a, b};
}
struct EpiG1 {
    static constexpr bool PERM = true; static constexpr bool MID = false;
    unsigned char* ws; const float* bgate;
    __device__ __forceinline__ void generic(const f32x4 (&acc)[2][2][4][2], const pg::Unit& u, int wr, int wc, int fr, int fq) const {
        const int pn = u.pn;
        bf16_t* const AG = (bf16_t*)(ws + WS_AG); bf16_t* const UMETA = (bf16_t*)(ws + WS_UMETA); bf16_t* const Q = (bf16_t*)(ws + WS_Q);
        bf16_t* const K = (bf16_t*)(ws + WS_K); bf16_t* const V = (bf16_t*)(ws + WS_V); bf16_t* const GATES = (bf16_t*)(ws + WS_GATES);
        EPI_LOOP_BEGIN
            const int c0 = pn * 256 + bj * 128 + wc * 32 + 8 * fq;
            f32x4 v0 = acc[ai][bj][m][0] * (1.0f / 512.0f), v1 = acc[ai][bj][m][1] * (1.0f / 512.0f);
            bf16_t* dst = nullptr;
            if (pn < 4) {
                if (row < TOK) { const int g = c0 >> 4, ch = c0 & 15; dst = AG + ((size_t)g * NCHUNK + (row >> 6)) * LDA_G + (row & 63) * 16 + ch; }
                else if (row < TOK + N_META) dst = UMETA + (size_t)(row - TOK) * 1024 + c0;
            } else if (pn < 8) {
                if (row < TOK) { dst = Q + (size_t)row * 1024 + (c0 - 1024); const float sc = 0.08838834764831845f * LOG2E; v0 = v0 * sc; v1 = v1 * sc; }
            } else if (pn == 8) { if (row < TOK + N_META) dst = K + (size_t)row * 256 + (c0 - 2048);
            } else if (pn == 9) { if (row < TOK + N_META) dst = V + (size_t)row * 256 + (c0 - 2304);
            } else {
                if (row < TOK) { const int cg_ = c0 - 2560;
                    const f32x4 b0 = *(const f32x4*)(bgate + cg_), b1 = *(const f32x4*)(bgate + cg_ + 4);
#pragma unroll
                    for (int j = 0; j < 4; ++j) { v0[j] = sigmoidf_(v0[j] + b0[j]); v1[j] = sigmoidf_(v1[j] + b1[j]); }
                    const size_t tile = (size_t)u.pm * 16 + (pn - 10); const int idx = (ai * 4 + m) * 2 + bj;
                    *(u32x2*)((unsigned char*)GATES + ((tile * 8 + (wr * 4 + wc)) * 16 + idx) * 512 + (fr + 16 * fq) * 8) = gates_pack8(v0, v1); }
            }
            if (dst) { u32x4 w; w.x = cvt_pk_bf16(v0[0], v0[1]); w.y = cvt_pk_bf16(v0[2], v0[3]); w.z = cvt_pk_bf16(v1[0], v1[1]); w.w = cvt_pk_bf16(v1[2], v1[3]); *(u32x4*)dst = w; }
        EPI_LOOP_END
    }
    __device__ __forceinline__ void operator()(const f32x4 (&acc)[2][2][4][2], const pg::Unit& u, int wr, int wc, int fr, int fq) const {
        const int pn = u.pn;
        if (u.pm >= TOK / 256) { generic(acc, u, wr, wc, fr, fq); return; }
#define EPI_PACK(w_, v0_, v1_) u32x4 w_; w_.x = cvt_pk_bf16(v0_[0], v0_[1]); w_.y = cvt_pk_bf16(v0_[2], v0_[3]); w_.z = cvt_pk_bf16(v1_[0], v1_[1]); w_.w = cvt_pk_bf16(v1_[2], v1_[3])
        if (pn >= 10) {
            bf16_t* const GATES = (bf16_t*)(ws + WS_GATES);
            f32x4 gb[2][2];
#pragma unroll
            for (int bj = 0; bj < 2; ++bj) { const int cg_ = pn * 256 - 2560 + bj * 128 + wc * 32 + 8 * fq; gb[bj][0] = *(const f32x4*)(bgate + cg_) * (-LOG2E); gb[bj][1] = *(const f32x4*)(bgate + cg_ + 4) * (-LOG2E); }
            const size_t tile = (size_t)u.pm * 16 + (pn - 10);
            constexpr float kz = -LOG2E / 512.0f, q255 = 1.0f / 255.0f;
            EPI_LOOP_BEGIN
                f32x4 v0, v1;
#pragma unroll
                for (int j = 0; j < 4; ++j) {
                    v0[j] = __builtin_amdgcn_rcpf(__builtin_fmaf(__builtin_amdgcn_exp2f(__builtin_fmaf(acc[ai][bj][m][0][j], kz, gb[bj][0][j])), q255, q255));
                    v1[j] = __builtin_amdgcn_rcpf(__builtin_fmaf(__builtin_amdgcn_exp2f(__builtin_fmaf(acc[ai][bj][m][1][j], kz, gb[bj][1][j])), q255, q255)); }
                const int idx = (ai * 4 + m) * 2 + bj; (void)row;
                unsigned a_ = 0u, b_ = 0u;
                a_ = __builtin_amdgcn_cvt_pk_u8_f32(v0[0], 0, a_); a_ = __builtin_amdgcn_cvt_pk_u8_f32(v0[1], 1, a_); a_ = __builtin_amdgcn_cvt_pk_u8_f32(v0[2], 2, a_); a_ = __builtin_amdgcn_cvt_pk_u8_f32(v0[3], 3, a_);
                b_ = __builtin_amdgcn_cvt_pk_u8_f32(v1[0], 0, b_); b_ = __builtin_amdgcn_cvt_pk_u8_f32(v1[1], 1, b_); b_ = __builtin_amdgcn_cvt_pk_u8_f32(v1[2], 2, b_); b_ = __builtin_amdgcn_cvt_pk_u8_f32(v1[3], 3, b_);
                *(u32x2*)((unsigned char*)GATES + ((tile * 8 + (wr * 4 + wc)) * 16 + idx) * 512 + (fr + 16 * fq) * 8) = (u32x2){a_, b_};
            EPI_LOOP_END
        } else if (pn < 4) {
            bf16_t* const AG = (bf16_t*)(ws + WS_AG);
            EPI_LOOP_BEGIN
                const int c0 = pn * 256 + bj * 128 + wc * 32 + 8 * fq; const int g = c0 >> 4, ch = c0 & 15;
                const f32x4 v0 = acc[ai][bj][m][0] * (1.0f / 512.0f), v1 = acc[ai][bj][m][1] * (1.0f / 512.0f);
                EPI_PACK(w, v0, v1);
                *(u32x4*)(AG + ((size_t)g * NCHUNK + (row >> 6)) * LDA_G + (row & 63) * 16 + ch) = w;
            EPI_LOOP_END
        } else {
            bf16_t* const base = pn < 8 ? (bf16_t*)(ws + WS_Q) : pn == 8 ? (bf16_t*)(ws + WS_K) : (bf16_t*)(ws + WS_V);
            const int ld = pn < 8 ? 1024 : 256, coff = pn < 8 ? 1024 : pn == 8 ? 2048 : 2304;
            const float sc = (pn < 8 ? 0.08838834764831845f * LOG2E : 1.0f) * (1.0f / 512.0f);
            EPI_LOOP_BEGIN
                const int c0 = pn * 256 + bj * 128 + wc * 32 + 8 * fq;
                const f32x4 v0 = acc[ai][bj][m][0] * sc, v1 = acc[ai][bj][m][1] * sc;
                EPI_PACK(w, v0, v1);
                *(u32x4*)(base + (size_t)row * ld + (c0 - coff)) = w;
            EPI_LOOP_END
        }
#undef EPI_PACK
    }
};
struct EpiGates {
    static constexpr bool PERM = true;
    unsigned char* GATES; const float* bgate;
    __device__ __forceinline__ void operator()(const f32x4 (&acc)[2][2][4][2], const pg::Unit& u, int wr, int wc, int fr, int fq) const {
        asm volatile("" : "+v"(fr), "+v"(fq));
        EPI_LOOP_BEGIN
            (void)row; const int cg_ = u.pn * 256 + bj * 128 + wc * 32 + 8 * fq;
            f32x4 v0 = acc[ai][bj][m][0] * (1.0f / 512.0f), v1 = acc[ai][bj][m][1] * (1.0f / 512.0f);
            const f32x4 b0 = *(const f32x4*)(bgate + cg_), b1 = *(const f32x4*)(bgate + cg_ + 4);
#pragma unroll
            for (int j = 0; j < 4; ++j) { v0[j] = sigmoidf_(v0[j] + b0[j]); v1[j] = sigmoidf_(v1[j] + b1[j]); }
            const size_t tile = (size_t)u.pm * 16 + u.pn; const int idx = (ai * 4 + m) * 2 + bj;
            u32x4 w; w.x = cvt_pk_bf16(v0[0], v0[1]); w.y = cvt_pk_bf16(v0[2], v0[3]); w.z = cvt_pk_bf16(v1[0], v1[1]); w.w = cvt_pk_bf16(v1[2], v1[3]);
            *(u32x4*)(GATES + ((tile * 8 + (wr * 4 + wc)) * 16 + idx) * 1024 + (fr + 16 * fq) * 16) = w;
        EPI_LOOP_END
    }
};
struct EpiG2 {
    static constexpr bool PERM = false;
    float* S;
    __device__ __forceinline__ void operator()(const f32x4 (&acc)[2][2][4][2], const pg::Unit& u, int wr, int wc, int fr, int fq) const {
        EPI_LOOP_BEGIN
#pragma unroll
            for (int n = 0; n < 2; ++n) { const int c = bj * 128 + wc * 32 + 16 * n + 4 * fq; *(f32x4*)(S + ((size_t)u.grp * NCHUNK + row) * 256 + c) = acc[ai][bj][m][n]; }
        EPI_LOOP_END
    }
};
struct EpiG3 {
    static constexpr bool PERM = true;
    const bf16_t* AG; const float* dskip; bf16_t* YAPRE;
    __device__ __forceinline__ void operator()(const f32x4 (&acc)[2][2][4][2], const pg::Unit& u, int wr, int wc, int fr, int fq) const {
        const int g = u.grp;
        u32x4 uq[16];
        const int chq = (8 * fq) & 15;
        const f32x4 d0 = *(const f32x4*)(dskip + g * 16 + chq), d1 = *(const f32x4*)(dskip + g * 16 + chq + 4);
        EPI_BATCH_BEGIN(0, 2)
            const int c0 = u.pn * 256 + bj * 128 + wc * 32 + 8 * fq;
            uq[ck] = *(const u32x4*)(AG + ((size_t)g * NCHUNK + row) * LDA_G + c0);
        EPI_BATCH_END
        EPI_BATCH_BEGIN(0, 2)
            const int c0 = u.pn * 256 + bj * 128 + wc * 32 + 8 * fq;
            const int tp = c0 >> 4, ch = c0 & 15;
            const u32x4 uu = uq[ck];
            const f32x4 v0 = acc[ai][bj][m][0], v1 = acc[ai][bj][m][1];
            float y[8];
            y[0] = v0[0] + d0[0] * bf_lo(uu.x); y[1] = v0[1] + d0[1] * bf_hi(uu.x); y[2] = v0[2] + d0[2] * bf_lo(uu.y); y[3] = v0[3] + d0[3] * bf_hi(uu.y);
            y[4] = v1[0] + d1[0] * bf_lo(uu.z); y[5] = v1[1] + d1[1] * bf_hi(uu.z); y[6] = v1[2] + d1[2] * bf_lo(uu.w); y[7] = v1[3] + d1[3] * bf_hi(uu.w);
#pragma unroll
            for (int j = 0; j < 8; ++j) y[j] = gelu_tanh(y[j]);
            u32x4 w; w.x = cvt_pk_bf16(y[0], y[1]); w.y = cvt_pk_bf16(y[2], y[3]); w.z = cvt_pk_bf16(y[4], y[5]); w.w = cvt_pk_bf16(y[6], y[7]);
            *(u32x4*)(YAPRE + ((size_t)row * 64 + tp) * 1024 + g * 16 + ch) = w;
        EPI_BATCH_END
    }
};
template <int MODE> struct EpiBf {
    static constexpr bool PERM = true;
    bf16_t* O; int ldo; const bf16_t* aux; int ldaux; const bf16_t* gate; const float* bias; const float* rss;
    static constexpr float ascale = (MODE == 1 || MODE == 2) ? 1.0f / 256.0f : 1.0f;
    __device__ __forceinline__ void operator()(const f32x4 (&acc)[2][2][4][2], const pg::Unit& u, int wr, int wc, int fr, int fq) const {
        constexpr int NB = (MODE == 2) ? 2 : 1;
        const int wv = wr * 4 + wc, ln = fr + 16 * fq;
        f32x4 bia[2][2];
        if (MODE == 0) {
#pragma unroll
            for (int bj = 0; bj < 2; ++bj) { const int c0 = u.pn * 256 + bj * 128 + wc * 32 + 8 * fq; bia[bj][0] = *(const f32x4*)(bias + c0); bia[bj][1] = *(const f32x4*)(bias + c0 + 4); } }
#pragma unroll
        for (int bb = 0; bb < NB; ++bb) { const int ai0 = bb * (2 / NB), ai1 = ai0 + 2 / NB;
            u32x4 LA[16 / NB], LB[MODE == 2 ? 16 / NB : 1];
            if (MODE != 3) {
                EPI_BATCH_BEGIN(ai0, ai1)
                    const int c0 = u.pn * 256 + bj * 128 + wc * 32 + 8 * fq; (void)c0;
                    if (MODE == 0) LA[ck] = *(const u32x4*)(aux + (size_t)row * ldaux + c0);
                    else { const int idx = (ai * 4 + m) * 2 + bj; const size_t gtile = (size_t)u.pm * 16 + (MODE == 2 ? 8 : 0) + u.pn, mtile = (size_t)u.pm * 8 + u.pn;
                        { const u32x2 t_ = *(const u32x2*)((const unsigned char*)gate + ((gtile * 8 + wv) * 16 + idx) * 512 + ln * 8); LA[ck] = (u32x4){t_.x, t_.y, 0u, 0u}; }
                        if (MODE == 2) LB[ck] = *(const u32x4*)((const unsigned char*)aux + ((mtile * 8 + wv) * 16 + idx) * 1024 + ln * 16); }
                EPI_BATCH_END
            }
            EPI_BATCH_BEGIN(ai0, ai1)
                const int c0 = u.pn * 256 + bj * 128 + wc * 32 + 8 * fq;
                const f32x4 v0 = acc[ai][bj][m][0] * ascale, v1 = acc[ai][bj][m][1] * ascale;
                float y[8] = {v0[0], v0[1], v0[2], v0[3], v1[0], v1[1], v1[2], v1[3]};
                if (MODE == 0) {
                    const u32x4 a = LA[ck];
                    const f32x4 b0 = bia[bj][0], b1 = bia[bj][1];
                    const float yy[8] = {bf_lo(a.x), bf_hi(a.x), bf_lo(a.y), bf_hi(a.y), bf_lo(a.z), bf_hi(a.z), bf_lo(a.w), bf_hi(a.w)};
                    const float bb_[8] = {b0[0], b0[1], b0[2], b0[3], b1[0], b1[1], b1[2], b1[3]};
#pragma unroll
                    for (int j = 0; j < 8; ++j) y[j] = yy[j] * sigmoidf_(y[j] + bb_[j]);
                } else if (MODE == 1 || MODE == 2) {
                    const int idx = (ai * 4 + m) * 2 + bj;
                    const size_t mtile = (size_t)u.pm * 8 + u.pn;
                    const u32x4 gq = LA[ck];
                    constexpr float q8 = 1.0f / 255.0f;
                    const float gg[8] = {q8 * (float)(gq.x & 0xffu), q8 * (float)((gq.x >> 8) & 0xffu), q8 * (float)((gq.x >> 16) & 0xffu), q8 * (float)(gq.x >> 24),
                                         q8 * (float)(gq.y & 0xffu), q8 * (float)((gq.y >> 8) & 0xffu), q8 * (float)((gq.y >> 16) & 0xffu), q8 * (float)(gq.y >> 24)};
                    if (MODE == 1) {
                        u32x4* mp = (u32x4*)((unsigned char*)O + ((mtile * 8 + wv) * 16 + idx) * 1024 + ln * 16);
#pragma unroll
                        for (int j = 0; j < 8; ++j) y[j] = (DBG & 4) ? 0.f : gg[j] * y[j];
                        u32x4 w; w.x = cvt_pk_bf16(y[0], y[1]); w.y = cvt_pk_bf16(y[2], y[3]); w.z = cvt_pk_bf16(y[4], y[5]); w.w = cvt_pk_bf16(y[6], y[7]);
                        *mp = w; continue;
                    } else {
                        const u32x4 a = LB[ck];
                        const float aa[8] = {bf_lo(a.x), bf_hi(a.x), bf_lo(a.y), bf_hi(a.y), bf_lo(a.z), bf_hi(a.z), bf_lo(a.w), bf_hi(a.w)};
                        float z[8];
#pragma unroll
                        for (int j = 0; j < 8; ++j) z[j] = 16.f * ((DBG & 8) ? aa[j] : aa[j] + gg[j] * y[j]);
                        int p0 = __builtin_amdgcn_cvt_pk_fp8_f32(z[0], z[1], 0, false); p0 = __builtin_amdgcn_cvt_pk_fp8_f32(z[2], z[3], p0, true);
                        int p1 = __builtin_amdgcn_cvt_pk_fp8_f32(z[4], z[5], 0, false); p1 = __builtin_amdgcn_cvt_pk_fp8_f32(z[6], z[7], p1, true);
                        *(u32x2*)((unsigned char*)O + (size_t)row * ldo + c0) = (u32x2){(unsigned)p0, (unsigned)p1}; continue;
                    }
                }
                if (MODE == 0) {
                    int p0 = __builtin_amdgcn_cvt_pk_fp8_f32(y[0], y[1], 0, false); p0 = __builtin_amdgcn_cvt_pk_fp8_f32(y[2], y[3], p0, true);
                    int p1 = __builtin_amdgcn_cvt_pk_fp8_f32(y[4], y[5], 0, false); p1 = __builtin_amdgcn_cvt_pk_fp8_f32(y[6], y[7], p1, true);
                    *(u32x2*)((unsigned char*)O + (size_t)row * ldo + c0) = (u32x2){(unsigned)p0, (unsigned)p1}; continue; }
                u32x4 w; w.x = cvt_pk_bf16(y[0], y[1]); w.y = cvt_pk_bf16(y[2], y[3]); w.z = cvt_pk_bf16(y[4], y[5]); w.w = cvt_pk_bf16(y[6], y[7]);
                *(u32x4*)(O + (size_t)row * ldo + c0) = w;
            EPI_BATCH_END
        }
    }
};
struct EpiG6 {
    static constexpr bool PERM = true;
    const float* x; bf16_t* HS1B; float* rss;
    __device__ __forceinline__ void operator()(const f32x4 (&acc)[2][2][4][2], const pg::Unit& u, int wr, int wc, int fr, int fq) const {
#pragma unroll
        for (int ai = 0; ai < 2; ++ai) {
            f32x4 xq[4][2][2];
#pragma unroll
            for (int m = 0; m < 4; ++m) { const int row = u.pm * 256 + ai * 128 + wr * 64 + m * 16 + fr;
#pragma unroll
                for (int bj = 0; bj < 2; ++bj) { const int c0 = u.pn * 256 + bj * 128 + wc * 32 + 8 * fq; const f32x4* xp = (const f32x4*)(x + (size_t)row * 2048 + c0); xq[m][bj][0] = xp[0]; xq[m][bj][1] = xp[1]; } }
#pragma unroll
            for (int m = 0; m < 4; ++m) { const int row = u.pm * 256 + ai * 128 + wr * 64 + m * 16 + fr; float ss = 0.f;
#pragma unroll
                for (int bj = 0; bj < 2; ++bj) { const int c0 = u.pn * 256 + bj * 128 + wc * 32 + 8 * fq;
                    const f32x4 h0 = (DBG & 1) ? xq[m][bj][0] : xq[m][bj][0] + acc[ai][bj][m][0] * (1.0f / 8192.0f);
                    const f32x4 h1 = (DBG & 1) ? xq[m][bj][1] : xq[m][bj][1] + acc[ai][bj][m][1] * (1.0f / 8192.0f);
                    ss += ((h0[0] * h0[0] + h0[1] * h0[1]) + (h0[2] * h0[2] + h0[3] * h0[3])) + ((h1[0] * h1[0] + h1[1] * h1[1]) + (h1[2] * h1[2] + h1[3] * h1[3]));
                    u32x4 w; w.x = cvt_pk_bf16(h0[0], h0[1]); w.y = cvt_pk_bf16(h0[2], h0[3]); w.z = cvt_pk_bf16(h1[0], h1[1]); w.w = cvt_pk_bf16(h1[2], h1[3]);
                    *(u32x4*)(HS1B + (size_t)row * 2048 + c0) = w; }
                ss += __shfl_xor(ss, 16); ss += __shfl_xor(ss, 32);
                if (fq == 0) rss[(size_t)row * 32 + u.pn * 4 + wc] = ss; } }
    }
};

struct Args {
    const float* x; const float* meta; const float* norm_mix; const float* w_in; const float* b_gate;
    const float* lam_re; const float* lam_im; const float* log_dt; const float* b_re; const float* b_im; const float* c_re; const float* c_im;
    const float* ssm_d; const float* w_glu; const float* b_glu; const float* sink; const float* w_ps; const float* w_pa; const float* w_out;
    const float* norm_ffn; const float* w_q; const float* pk1; const float* pk2; const float* pu; const float* pv; const float* norm_final;
    float* out; unsigned char* ws; int ph_lo, ph_hi;
};

__device__ __forceinline__ void p0_transpose_item(const float* W, int K, int N, bf16_t* WT, LAS float* scr, int item, int lane, const float* rowgain = nullptr, unsigned char* WT8 = nullptr, int n8_0 = 0, float s8 = 512.f) {
    const int nblk = N / 32, kb = item / nblk, nb = item % nblk, k0 = 64 * kb, n0 = 32 * nb;
    { f32x4 t[8]; float gs[8];
#pragma unroll
      for (int g = 0; g < 8; ++g) { const int kk = 8 * g + (lane >> 3); t[g] = *(const f32x4*)(W + (size_t)(k0 + kk) * N + n0 + 4 * (lane & 7)); gs[g] = rowgain ? rowgain[k0 + kk] : 1.0f; }
#pragma unroll
      for (int g = 0; g < 8; ++g) { const int kk = 8 * g + (lane >> 3); LAS float* d = scr + kk * 33 + 4 * (lane & 7);
          d[0] = gs[g] * t[g][0]; d[1] = gs[g] * t[g][1]; d[2] = gs[g] * t[g][2]; d[3] = gs[g] * t[g][3]; } }
    LDS_WAIT(); asm volatile("" ::: "memory");
    const int c = lane & 7;
#pragma unroll
    for (int j = 0; j < 4; ++j) { const int n = (lane >> 3) + 8 * j; const LAS float* s = scr + (8 * c) * 33 + n;
        u32x4 o; o.x = cvt_pk_bf16(s[0 * 33], s[1 * 33]); o.y = cvt_pk_bf16(s[2 * 33], s[3 * 33]); o.z = cvt_pk_bf16(s[4 * 33], s[5 * 33]); o.w = cvt_pk_bf16(s[6 * 33], s[7 * 33]);
        if (WT) *(u32x4*)(WT + (size_t)(n0 + n) * K + k0 + 8 * c) = o;
        if (WT8 && n0 >= n8_0) { int p0 = __builtin_amdgcn_cvt_pk_fp8_f32(s8 * s[0 * 33], s8 * s[1 * 33], 0, false); p0 = __builtin_amdgcn_cvt_pk_fp8_f32(s8 * s[2 * 33], s8 * s[3 * 33], p0, true);
            int p1 = __builtin_amdgcn_cvt_pk_fp8_f32(s8 * s[4 * 33], s8 * s[5 * 33], 0, false); p1 = __builtin_amdgcn_cvt_pk_fp8_f32(s8 * s[6 * 33], s8 * s[7 * 33], p1, true);
            *(u32x2*)(WT8 + (size_t)(n0 + n - n8_0) * K + k0 + 8 * c) = (u32x2){(unsigned)p0, (unsigned)p1}; } }
    LDS_WAIT(); asm volatile("" ::: "memory");
}
__device__ __forceinline__ void rowA_load(const float* src, int lane, f32x4 (&v)[8]) {
#pragma unroll
    for (int i = 0; i < 4; ++i) { const f32x4* p = (const f32x4*)(src + (i * 64 + lane) * 8); v[2 * i] = p[0]; v[2 * i + 1] = p[1]; }
}
__device__ __forceinline__ void rowA_finish(const f32x4 (&v)[8], bf16_t* dst, int lane, bool norm, const float* gain, unsigned char* dst8, const f32x4* gpre = nullptr) {
    float rs = 1.0f;
    if (norm) { float s = 0.f;
#pragma unroll
        for (int i = 0; i < 8; ++i) s += (v[i][0] * v[i][0] + v[i][1] * v[i][1]) + (v[i][2] * v[i][2] + v[i][3] * v[i][3]);
        rs = 1.0f / sqrtf(wave_sum(s) * (1.0f / 2048.0f) + NORM_EPS); }
#pragma unroll
    for (int i = 0; i < 4; ++i) { f32x4 a = v[2 * i] * rs, b = v[2 * i + 1] * rs;
        if (norm) { if (gpre) { a = a * gpre[2 * i]; b = b * gpre[2 * i + 1]; }
                    else { const f32x4* gp = (const f32x4*)(gain + (i * 64 + lane) * 8); a = a * gp[0]; b = b * gp[1]; } }
        u32x4 w; w.x = cvt_pk_bf16(a[0], a[1]); w.y = cvt_pk_bf16(a[2], a[3]); w.z = cvt_pk_bf16(b[0], b[1]); w.w = cvt_pk_bf16(b[2], b[3]);
        if (dst) *(u32x4*)(dst + (i * 64 + lane) * 8) = w;
        if (dst8) { int p0 = __builtin_amdgcn_cvt_pk_fp8_f32(a[0], a[1], 0, false); p0 = __builtin_amdgcn_cvt_pk_fp8_f32(a[2], a[3], p0, true);
            int p1 = __builtin_amdgcn_cvt_pk_fp8_f32(b[0], b[1], 0, false); p1 = __builtin_amdgcn_cvt_pk_fp8_f32(b[2], b[3], p1, true);
            *(u32x2*)(dst8 + (i * 64 + lane) * 8) = (u32x2){(unsigned)p0, (unsigned)p1}; } }
}
__device__ __forceinline__ void row_to_bf16(const float* src, bf16_t* dst, int lane, bool norm, const float* gain, unsigned char* dst8 = nullptr) {
    f32x4 v[8]; rowA_load(src, lane, v); rowA_finish(v, dst, lane, norm, gain, dst8);
}
__device__ __forceinline__ void row_to_fp8(const float* src, unsigned char* dst, float* inv, int lane, const float* gain) {
    f32x4 v[8]; float am = 0.f;
#pragma unroll
    for (int i = 0; i < 2; ++i)
#pragma unroll
        for (int j = 0; j < 4; ++j) { v[4 * i + j] = *(const f32x4*)(src + (i * 64 + lane) * 16 + 4 * j) * *(const f32x4*)(gain + (i * 64 + lane) * 16 + 4 * j);
            am = fmaxf(am, fmaxf(fmaxf(fabsf(v[4 * i + j][0]), fabsf(v[4 * i + j][1])), fmaxf(fabsf(v[4 * i + j][2]), fabsf(v[4 * i + j][3])))); }
#pragma unroll
    for (int o = 1; o < 64; o <<= 1) am = fmaxf(am, __shfl_xor(am, o));
    float sc = 1.0f, isc = 1.0f;
    if (am > 0.f) { const float e = floorf(log2f(224.0f / am)); sc = exp2f(e); isc = exp2f(-e); }
    if (lane == 0) *inv = isc;
#pragma unroll
    for (int i = 0; i < 2; ++i) { u32x4 w;
#pragma unroll
        for (int j = 0; j < 4; ++j) { const f32x4 x = v[4 * i + j] * sc; int pk = __builtin_amdgcn_cvt_pk_fp8_f32(x[0], x[1], 0, false); pk = __builtin_amdgcn_cvt_pk_fp8_f32(x[2], x[3], pk, true); w[j] = (unsigned)pk; }
        *(u32x4*)(dst + (i * 64 + lane) * 16) = w; }
}
#ifndef FMT6
#define FMT6 1
#endif
#ifndef HWPK4
#define HWPK4 1
#endif
#define SC4_BIAS 840
#ifndef TIME_DOTS
#define TIME_DOTS 0
#endif
#ifndef DOTS_PROBE
#define DOTS_PROBE 0
#endif
#ifndef MFMA_A
#define MFMA_A 1
#endif
#define X8_IN_TOPK 1
#ifndef UFMT4
#define UFMT4 1
#endif
__device__ __forceinline__ void rowB_load(const float* src, int lane, f32x4 (&v)[8]) {
#pragma unroll
    for (int j = 0; j < 8; ++j) v[j] = *(const f32x4*)(src + (j * 64 + lane) * 4);
}
__device__ __forceinline__ void fp6_finish(const f32x4 (&vin)[8], unsigned char* dst, float* inv, int lane, const float* gain) {
    f32x16 va, vb; float am = 0.f;
#pragma unroll
    for (int j = 0; j < 8; ++j) { f32x4 v = vin[j]; if (gain) v = v * *(const f32x4*)(gain + (j * 64 + lane) * 4);
        am = fmaxf(am, fmaxf(fmaxf(fabsf(v[0]), fabsf(v[1])), fmaxf(fabsf(v[2]), fabsf(v[3]))));
        va[2 * j] = v[0]; vb[2 * j] = v[1]; va[2 * j + 1] = v[2]; vb[2 * j + 1] = v[3]; }
#pragma unroll
    for (int o = 1; o < 64; o <<= 1) am = fmaxf(am, __shfl_xor(am, o));
    float sc = 1.0f, isc = 1.0f;
    if (am > 0.f) { const float e = floorf(log2f(7.5f / am)); sc = exp2f(e); isc = exp2f(-e); }
    if (lane == 0) *inv = isc;
    va = va * sc; vb = vb * sc;
    const u32x6 r = __builtin_amdgcn_cvt_scalef32_2xpk16_fp6_f32(va, vb, 1.0f);
    *(u32x4*)(dst + 16 * lane) = (u32x4){r[0], r[1], r[2], r[3]};
    *(u32x2*)(dst + 1024 + 8 * lane) = (u32x2){r[4], r[5]};
}
__device__ __forceinline__ void row_to_fp6(const float* src, unsigned char* dst, float* inv, int lane, const float* gain = nullptr) {
    f32x4 v[8]; rowB_load(src, lane, v); fp6_finish(v, dst, inv, lane, gain);
}
template <bool E8 = false>
__device__ __forceinline__ void fp4_finish(const f32x4 (&vin)[8], unsigned char* dst, unsigned char* scl, int lane, const float* gain = nullptr, const f32x4* gpre = nullptr) {
    f32x4 v[8]; float am = 0.f;
#pragma unroll
    for (int j = 0; j < 8; ++j) v[j] = vin[j];
    if (gpre) {
#pragma unroll
        for (int j = 0; j < 8; ++j) v[j] = v[j] * gpre[j];
    } else if (gain) {
        f32x4 g[8];
#pragma unroll
        for (int j = 0; j < 8; ++j) g[j] = *(const f32x4*)(gain + (j * 64 + lane) * 4);
#pragma unroll
        for (int j = 0; j < 8; ++j) v[j] = v[j] * g[j];
    }
#pragma unroll
    for (int j = 0; j < 8; ++j) am = fmaxf(am, fmaxf(fmaxf(fabsf(v[j][0]), fabsf(v[j][1])), fmaxf(fabsf(v[j][2]), fabsf(v[j][3]))));
    float sc;
    if constexpr (E8) {
        sc = 1.0f; int eb = 127; if (am > 0.f) { const float e = fminf(floorf(log2f(6.0f / am)), 126.f); sc = exp2f(e); eb = 127 - (int)e; }
        scl[(lane & 3) * 16 + (lane >> 2)] = (unsigned char)eb;
    } else {
        int cb = (int)((__float_as_uint(am * (1.0f / 6.0f)) + (1u << 19)) >> 20) - SC4_BIAS; cb = cb < 0 ? 0 : (cb > 255 ? 255 : cb);
        sc = 1.0f / __uint_as_float((unsigned)(cb + SC4_BIAS) << 20);
        scl[lane] = (unsigned char)cb; }
    u32x4 w = {0u, 0u, 0u, 0u};
#if HWPK4
#pragma unroll
    for (int d = 0; d < 4; ++d) { unsigned x = 0u;
        x = __builtin_amdgcn_cvt_scalef32_pk_fp4_f32(x, v[2 * d][0] * sc, v[2 * d][1] * sc, 1.0f, 0);
        x = __builtin_amdgcn_cvt_scalef32_pk_fp4_f32(x, v[2 * d][2] * sc, v[2 * d][3] * sc, 1.0f, 1);
        x = __builtin_amdgcn_cvt_scalef32_pk_fp4_f32(x, v[2 * d + 1][0] * sc, v[2 * d + 1][1] * sc, 1.0f, 2);
        x = __builtin_amdgcn_cvt_scalef32_pk_fp4_f32(x, v[2 * d + 1][2] * sc, v[2 * d + 1][3] * sc, 1.0f, 3);
        w[d] = x; }
#else
#pragma unroll
    for (int j = 0; j < 8; ++j)
#pragma unroll
        for (int q = 0; q < 4; ++q) { const float y = v[j][q] * sc, a = fabsf(y);
            const unsigned code = (unsigned)(a > 0.25f) + (unsigned)(a > 0.75f) + (unsigned)(a > 1.25f) + (unsigned)(a > 1.75f) + (unsigned)(a > 2.5f) + (unsigned)(a > 3.5f) + (unsigned)(a > 5.0f) + ((__float_as_uint(y) >> 31) << 3);
            const int i = 4 * j + q; w[i >> 3] |= code << (4 * (i & 7)); }
#endif
    *(u32x4*)(dst + 16 * lane) = w;
}
template <bool E8 = false>
__device__ __forceinline__ void row_to_fp4(const float* src, unsigned char* dst, unsigned char* scl, int lane, const float* gain = nullptr) {
    f32x4 v[8]; rowB_load(src, lane, v); fp4_finish<E8>(v, dst, scl, lane, gain);
}
__device__ __forceinline__ void p0_s5_tables(const Args& a, LAS unsigned char* lds, int g) {
    LAS float* apw = (LAS float*)lds;
    LAS float* Bb = apw + 2 * 65 * 64 * 2;
    LAS float* Cc = Bb + 2 * 64 * 16 * 2;
    const int tid = tid_fresh();
    unsigned char* ws = a.ws;
    float* S5M = (float*)(ws + WS_S5M);
    float* A64 = S5M; float* AP16 = S5M + 2 * 64 * 64 * 2; float* BB0 = AP16 + 64 * 64 * 16 * 2;
    if (tid < 128) {
        const int r = tid >> 6, p = tid & 63; const int gi = r * 64 + g;
        const double dt = exp((double)a.log_dt[gi]); const double lr = (double)a.lam_re[gi * 64 + p], li = (double)a.lam_im[gi * 64 + p];
        double a1r = 0, a1i = 0;
        const double m1 = exp(lr * dt), b1r = m1 * cos(li * dt), b1i = m1 * sin(li * dt);
        double cr = 1.0, ci = 0.0;
        for (int n = 0; n <= 64; ++n) { if (n > 0) { const double tr = cr * b1r - ci * b1i, ti = cr * b1i + ci * b1r; cr = tr; ci = ti; }
            apw[((r * 65 + n) * 64 + p) * 2] = (float)cr; apw[((r * 65 + n) * 64 + p) * 2 + 1] = (float)ci; if (n == 1) { a1r = cr; a1i = ci; }
            if (n == 64) { A64[(gi * 64 + p) * 2] = (float)cr; A64[(gi * 64 + p) * 2 + 1] = (float)ci; }
            if (r == 0 && n < 16) { AP16[((g * 64 + p) * 16 + n) * 2] = (float)cr; AP16[((g * 64 + p) * 16 + n) * 2 + 1] = (float)ci; } }
        const double den = lr * lr + li * li, nr = a1r - 1.0, ni = a1i;
        const double cre = (nr * lr + ni * li) / den, cim = (ni * lr - nr * li) / den;
        for (int c = 0; c < 16; ++c) { const double br = (double)a.b_re[(gi * 64 + p) * 16 + c], bi = (double)a.b_im[(gi * 64 + p) * 16 + c];
            const float zr = (float)(cre * br - cim * bi), zi = (float)(cre * bi + cim * br);
            Bb[((r * 64 + p) * 16 + c) * 2] = zr; Bb[((r * 64 + p) * 16 + c) * 2 + 1] = zi;
            if (r == 0) { BB0[((g * 64 + p) * 16 + c) * 2] = zr; BB0[((g * 64 + p) * 16 + c) * 2 + 1] = zi; } }
    }
    for (int idx = tid; idx < 2048; idx += NTHREADS) { const int r = idx >> 10, c = (idx >> 6) & 15, p = idx & 63; const int gi = r * 64 + g;
        Cc[idx * 2] = a.c_re[(gi * 16 + c) * 64 + p]; Cc[idx * 2 + 1] = a.c_im[(gi * 16 + c) * 64 + p]; }
    __syncthreads();
    bf16_t* KT = (bf16_t*)(ws + WS_KTAB) + (size_t)g * 128 * 256;
    for (int idx = tid; idx < 127 * 16; idx += NTHREADS) { const int dd = idx >> 4, c = idx & 15, d = dd - 63;
        float acc[16];
#pragma unroll
        for (int j = 0; j < 16; ++j) acc[j] = 0.f;
#pragma unroll
        for (int r = 0; r < 2; ++r) { if ((r == 0 && d < 0) || (r == 1 && d > 0)) continue; const int n = d < 0 ? -d : d;
            for (int p = 0; p < 64; ++p) { const float cr = Cc[((r * 16 + c) * 64 + p) * 2], ci = Cc[((r * 16 + c) * 64 + p) * 2 + 1];
                const float ar = apw[((r * 65 + n) * 64 + p) * 2], ai = apw[((r * 65 + n) * 64 + p) * 2 + 1];
                const float zr = cr * ar - ci * ai, zi = cr * ai + ci * ar; const LAS float* bp = Bb + ((r * 64 + p) * 16) * 2;
#pragma unroll
                for (int j = 0; j < 16; ++j) acc[j] += zr * bp[2 * j] - zi * bp[2 * j + 1]; } }
        u32x4 w0, w1; w0.x = cvt_pk_bf16(acc[0], acc[1]); w0.y = cvt_pk_bf16(acc[2], acc[3]); w0.z = cvt_pk_bf16(acc[4], acc[5]); w0.w = cvt_pk_bf16(acc[6], acc[7]);
        w1.x = cvt_pk_bf16(acc[8], acc[9]); w1.y = cvt_pk_bf16(acc[10], acc[11]); w1.z = cvt_pk_bf16(acc[12], acc[13]); w1.w = cvt_pk_bf16(acc[14], acc[15]);
        u32x4* o = (u32x4*)(KT + (size_t)dd * 256 + c * 16); o[0] = w0; o[1] = w1; }
    bf16_t* PT = (bf16_t*)(ws + WS_PT) + (size_t)g * 256 * 1024;
    for (int idx = tid; idx < 256 * 64; idx += NTHREADS) { const int n = idx >> 6, s = idx & 63; const int r = n >> 7, ri = (n >> 6) & 1, p = n & 63; const int e = r == 0 ? 63 - s : s;
        const float ar = apw[((r * 65 + e) * 64 + p) * 2], ai = apw[((r * 65 + e) * 64 + p) * 2 + 1]; const LAS float* bp = Bb + ((r * 64 + p) * 16) * 2; float v[16];
#pragma unroll
        for (int j = 0; j < 16; ++j) v[j] = ri ? (ar * bp[2 * j + 1] + ai * bp[2 * j]) : (ar * bp[2 * j] - ai * bp[2 * j + 1]);
        u32x4 w0, w1; w0.x = cvt_pk_bf16(v[0], v[1]); w0.y = cvt_pk_bf16(v[2], v[3]); w0.z = cvt_pk_bf16(v[4], v[5]); w0.w = cvt_pk_bf16(v[6], v[7]);
        w1.x = cvt_pk_bf16(v[8], v[9]); w1.y = cvt_pk_bf16(v[10], v[11]); w1.z = cvt_pk_bf16(v[12], v[13]); w1.w = cvt_pk_bf16(v[14], v[15]);
        u32x4* o = (u32x4*)(PT + (size_t)n * 1024 + s * 16); o[0] = w0; o[1] = w1; }
    bf16_t* QT = (bf16_t*)(ws + WS_QT) + (size_t)g * 1024 * 256;
    for (int idx = tid; idx < 1024 * 32; idx += NTHREADS) { const int n = idx >> 5, k0 = (idx & 31) * 8; const int t = n >> 4, c = n & 15; const int r = k0 >> 7, ri = (k0 >> 6) & 1, p0 = k0 & 63;
        const int e = r == 0 ? t + 1 : 64 - t; float v[8];
#pragma unroll
        for (int j = 0; j < 8; ++j) { const int p = p0 + j; const float cr = Cc[((r * 16 + c) * 64 + p) * 2], ci = Cc[((r * 16 + c) * 64 + p) * 2 + 1];
            const float ar = apw[((r * 65 + e) * 64 + p) * 2], ai = apw[((r * 65 + e) * 64 + p) * 2 + 1]; v[j] = ri ? -(cr * ai + ci * ar) : (cr * ar - ci * ai); }
        u32x4 w; w.x = cvt_pk_bf16(v[0], v[1]); w.y = cvt_pk_bf16(v[2], v[3]); w.z = cvt_pk_bf16(v[4], v[5]); w.w = cvt_pk_bf16(v[6], v[7]);
        *(u32x4*)(QT + (size_t)n * 256 + k0) = w; }
    __syncthreads();
}

__device__ __forceinline__ void p0_meta_proj(const Args& a, LAS unsigned char* lds, int task) {
    const int tid = tid_fresh(), lane = tid & 63, wave = tid >> 6;
    unsigned char* ws = a.ws;
    LAS bf16_t* MN = (LAS bf16_t*)lds; LAS float* RED = (LAS float*)(lds + 65536);
    const int cbase = task < 16 ? task * 64 : 2048 + (task - 16) * 64;
    __syncthreads();
#pragma unroll 1
    for (int rr = 0; rr < 2; ++rr) { const int t = 2 * wave + rr; f32x4 x[8]; float ss = 0.f;
#pragma unroll
        for (int j = 0; j < 8; ++j) { x[j] = *(const f32x4*)(a.meta + (size_t)t * 2048 + (j * 64 + lane) * 4); ss += (x[j][0] * x[j][0] + x[j][1] * x[j][1]) + (x[j][2] * x[j][2] + x[j][3] * x[j][3]); }
        const float rs = 1.0f / sqrtf(wave_sum(ss) * (1.0f / 2048.0f) + NORM_EPS);
#pragma unroll
        for (int j = 0; j < 8; ++j) { const f32x4 g = *(const f32x4*)(a.norm_mix + (j * 64 + lane) * 4);
#pragma unroll
            for (int e = 0; e < 4; ++e) { const int k = (j * 64 + lane) * 4 + e; MN[k * 16 + t] = (bf16_t)(cvt_pk_bf16(x[j][e] * rs * g[e], 0.f) & 0xffffu); } }
    }
    __syncthreads();
    float acc[16];
#pragma unroll
    for (int t = 0; t < 16; ++t) acc[t] = 0.f;
    const float* wp = a.w_in + (size_t)(256 * wave) * IN_COLS + cbase + lane;
#pragma unroll 1
    for (int k0 = 0; k0 < 256; k0 += 16) { float wv[16];
#pragma unroll
        for (int i = 0; i < 16; ++i) wv[i] = wp[(size_t)(k0 + i) * IN_COLS];
#pragma unroll
        for (int i = 0; i < 16; ++i) { const LAS u32x4* mp = (const LAS u32x4*)(MN + (256 * wave + k0 + i) * 16); const u32x4 m0 = mp[0], m1 = mp[1];
            acc[0] += wv[i] * bf_lo(m0.x); acc[1] += wv[i] * bf_hi(m0.x); acc[2] += wv[i] * bf_lo(m0.y); acc[3] += wv[i] * bf_hi(m0.y);
            acc[4] += wv[i] * bf_lo(m0.z); acc[5] += wv[i] * bf_hi(m0.z); acc[6] += wv[i] * bf_lo(m0.w); acc[7] += wv[i] * bf_hi(m0.w);
            acc[8] += wv[i] * bf_lo(m1.x); acc[9] += wv[i] * bf_hi(m1.x); acc[10] += wv[i] * bf_lo(m1.y); acc[11] += wv[i] * bf_hi(m1.y);
            acc[12] += wv[i] * bf_lo(m1.z); acc[13] += wv[i] * bf_hi(m1.z); acc[14] += wv[i] * bf_lo(m1.w); acc[15] += wv[i] * bf_hi(m1.w); } }
#pragma unroll
    for (int t = 0; t < 16; ++t) RED[(wave * 16 + t) * 64 + lane] = acc[t];
    __syncthreads();
    {   const int t = tid >> 5, cp = tid & 31; float s0 = 0.f, s1 = 0.f;
#pragma unroll
        for (int w = 0; w < 8; ++w) { s0 += RED[(w * 16 + t) * 64 + 2 * cp]; s1 += RED[(w * 16 + t) * 64 + 2 * cp + 1]; }
        const int c = cbase + 2 * cp; const unsigned pk = cvt_pk_bf16(s0, s1);
        bf16_t* dst = c < 1024 ? (bf16_t*)(ws + WS_UMETA) + (size_t)t * 1024 + c
                    : c < 2304 ? (bf16_t*)(ws + WS_K) + (size_t)(TOK + t) * 256 + (c - 2048)
                               : (bf16_t*)(ws + WS_V) + (size_t)(TOK + t) * 256 + (c - 2304);
        *(unsigned*)dst = pk; }
    __syncthreads();
}
__device__ __forceinline__ void phase0(const Args& a, LAS unsigned char* lds) {
    const int tid = tid_fresh(), lane = tid & 63, wave = tid >> 6, G = gridDim.x;
    unsigned char* ws = a.ws;
    for (int g = blockIdx.x; g < 64; g += G) p0_s5_tables(a, lds, g);
    __syncthreads();
    if (G >= 128) { if (blockIdx.x < 24) p0_meta_proj(a, lds, (int)blockIdx.x); }
    else for (int task = blockIdx.x; task < 24; task += G) p0_meta_proj(a, lds, task);
    const int gw = blockIdx.x * NWAVES + wave, NGW = G * NWAVES;
    LAS float* scr = (LAS float*)(lds + wave * 16384);
    constexpr int I_IN = 32 * 208, I_GLU = 16 * 32, I_PS = 16 * 64, I_OUT = 32 * 64;
    constexpr int NT_ITEMS = I_IN + I_GLU + 2 * I_PS + 2 * I_OUT;
    const bool tsplit = (G >= 128); const int gwT = tsplit ? (blockIdx.x - 64) * NWAVES + wave : gw, NGWT = tsplit ? (G - 64) * NWAVES : NGW;
    if (!tsplit || blockIdx.x >= 64)
    for (int it = gwT; it < NT_ITEMS; it += NGWT) {
        int r = it;
        if (r < I_IN) { p0_transpose_item(a.w_in, 2048, IN_COLS, nullptr, scr, r, lane, nullptr, ws + WS_WG8, 0); continue; } r -= I_IN;
        if (r < I_GLU) { p0_transpose_item(a.w_glu, 1024, 1024, (bf16_t*)(ws + WS_WGLU), scr, r, lane); continue; } r -= I_GLU;
        if (r < I_PS) { p0_transpose_item(a.w_ps, 1024, 2048, nullptr, scr, r, lane, nullptr, ws + WS_WP8, 0, 256.f); continue; } r -= I_PS;
        if (r < I_PS) { p0_transpose_item(a.w_pa, 1024, 2048, nullptr, scr, r, lane, nullptr, ws + WS_WP8 + 2048 * 1024, 0, 256.f); continue; } r -= I_PS;
        if (r < I_OUT) { p0_transpose_item(a.w_out, 2048, 2048, nullptr, scr, r, lane, nullptr, ws + WS_WOUT, 0, 512.f); continue; } r -= I_OUT;
        p0_transpose_item(a.w_q, 2048, 2048, (bf16_t*)(ws + WS_WQ), scr, r, lane, a.norm_ffn);
    }
    constexpr int R_NORM = MROWS, R_U = 16384, R_PK = 128;
    unsigned* rctr = (unsigned*)(ws + 32768 + 256);
    constexpr int R_TOTAL = R_NORM + 2 * R_U + R_PK;
    f32x4 gmix[8];
#pragma unroll
    for (int i = 0; i < 4; ++i) { const f32x4* gp = (const f32x4*)(a.norm_mix + (i * 64 + lane) * 8); gmix[2 * i] = gp[0]; gmix[2 * i + 1] = gp[1]; }
    for (;;) {
        unsigned base = 0u; if (lane == 0) base = __hip_atomic_fetch_add(rctr, 8u, __ATOMIC_RELAXED, __HIP_MEMORY_SCOPE_AGENT);
        base = (unsigned)__builtin_amdgcn_readfirstlane((int)base);
        if (base >= (unsigned)R_TOTAL) break;
      if ((int)base < TOK) {
#pragma unroll 1
          for (int h4 = 0; h4 < 2; ++h4) { f32x4 v[4][8]; const int r0 = (int)base + 4 * h4;
#pragma unroll
              for (int q = 0; q < 4; ++q) rowA_load(a.x + (size_t)(r0 + q) * 2048, lane, v[q]);
#pragma unroll
              for (int q = 0; q < 4; ++q) rowA_finish(v[q], nullptr, lane, true, a.norm_mix, ws + WS_HA8 + (size_t)(r0 + q) * 2048, gmix); }
          continue; }
      if ((int)base >= R_NORM && (int)base < R_NORM + 2 * R_U) {
          const bool isu = (int)base < R_NORM + R_U; const int rb = (int)base - R_NORM - (isu ? 0 : R_U);
#pragma unroll 1
          for (int h4 = 0; h4 < 2; ++h4) { f32x4 v[4][8]; const int r0 = rb + 4 * h4;
#pragma unroll
              for (int q = 0; q < 4; ++q) rowB_load((isu ? a.pu : a.pv) + (size_t)(r0 + q) * 2048, lane, v[q]);
              if (isu) {
#pragma unroll
                  for (int q = 0; q < 4; ++q) {
                      if (UFMT4) fp4_finish<MFMA_A != 0>(v[q], ws + WS_UT + (size_t)(r0 + q) * 1024, ws + WS_ISU + (size_t)(r0 + q) * 64, lane, a.norm_ffn);
                      else fp6_finish(v[q], ws + WS_UT + (size_t)(r0 + q) * 1536, (float*)(ws + WS_ISU) + r0 + q, lane, a.norm_ffn); }
              } else {
#pragma unroll
                  for (int q = 0; q < 4; ++q) fp4_finish(v[q], ws + WS_VT + (size_t)(r0 + q) * 1024, ws + WS_ISV + (size_t)(r0 + q) * 64, lane); } }
          continue; }
      for (int it = (int)base; it < (int)base + 8 && it < R_TOTAL; ++it) {
        int r = it;
        if (r < R_NORM) {
            unsigned char* dst8 = ws + WS_HA8 + (size_t)r * 2048;
            if (r < TOK) row_to_bf16(a.x + (size_t)r * 2048, nullptr, lane, true, a.norm_mix, dst8);
            else if (r < TOK + N_META) row_to_bf16(a.meta + (size_t)(r - TOK) * 2048, nullptr, lane, true, a.norm_mix, dst8);
            else { const u32x4 z = {0u, 0u, 0u, 0u};
#pragma unroll
                for (int i = 0; i < 2; ++i) *(u32x4*)(dst8 + (i * 64 + lane) * 16) = z; }
            continue; }
        r -= R_NORM;
        if (r < R_U) { if (UFMT4) row_to_fp4<MFMA_A != 0>(a.pu + (size_t)r * 2048, ws + WS_UT + (size_t)r * 1024, ws + WS_ISU + (size_t)r * 64, lane, a.norm_ffn);
                       else row_to_fp6(a.pu + (size_t)r * 2048, ws + WS_UT + (size_t)r * 1536, (float*)(ws + WS_ISU) + r, lane, a.norm_ffn); continue; } r -= R_U;
        if (r < R_U) { row_to_fp4(a.pv + (size_t)r * 2048, ws + WS_VT + (size_t)r * 1024, ws + WS_ISV + (size_t)r * 64, lane); continue; } r -= R_U;
        if (r < 64) row_to_bf16(a.pk1 + (size_t)r * 2048, (bf16_t*)(ws + WS_PK) + (size_t)r * 2048, lane, false, nullptr);
        else row_to_bf16(a.pk2 + (size_t)(r - 64) * 2048, (bf16_t*)(ws + WS_PK) + 131072 + (size_t)(r - 64) * 2048, lane, false, nullptr);
      }
    }
}

__device__ __forceinline__ void scan_unit(const Args& a, int g, int pm) {
    unsigned char* ws = a.ws; const int tid = tid_fresh();
    const float* S5M = (const float*)(ws + WS_S5M);
    const float* A64 = S5M; const float* AP16 = S5M + 2 * 64 * 64 * 2; const float* BB0 = AP16 + 64 * 64 * 16 * 2;
    const bf16_t* UM = (const bf16_t*)(ws + WS_UMETA);
    if (tid < 256) {
        const int b = 2 * pm + (tid >> 7), r = (tid >> 6) & 1, p = tid & 63;
        const float ar = A64[((r * 64 + g) * 64 + p) * 2], ai = A64[((r * 64 + g) * 64 + p) * 2 + 1];
        const float* S = (const float*)(ws + WS_S) + ((size_t)g * NCHUNK + b * 128) * 256 + r * 128 + p;
        bf16_t* H = (bf16_t*)(ws + WS_AG) + ((size_t)g * NCHUNK + b * 128) * LDA_G + 1024 + r * 128 + p;
        float hr = 0.f, hi = 0.f;
        if (r == 0) {
            for (int m = 0; m < 16; ++m) { const float pr = AP16[((g * 64 + p) * 16 + (15 - m)) * 2], pi = AP16[((g * 64 + p) * 16 + (15 - m)) * 2 + 1];
                float br = 0.f, bi = 0.f;
                for (int c = 0; c < 16; ++c) { const float uv = bf_lo((unsigned)UM[m * 1024 + g * 16 + c]); br += BB0[((g * 64 + p) * 16 + c) * 2] * uv; bi += BB0[((g * 64 + p) * 16 + c) * 2 + 1] * uv; }
                hr += pr * br - pi * bi; hi += pr * bi + pi * br; }
        }
        for (int cb = 0; cb < 128; cb += 16) {
            float sr[16], si[16];
#pragma unroll
            for (int j = 0; j < 16; ++j) { const int c = (r == 0) ? cb + j : 127 - cb - j; sr[j] = S[(size_t)c * 256]; si[j] = S[(size_t)c * 256 + 64]; }
#pragma unroll
            for (int j = 0; j < 16; ++j) { const int c = (r == 0) ? cb + j : 127 - cb - j;
                H[(size_t)c * LDA_G] = (bf16_t)(cvt_pk_bf16(hr, hr) & 0xffffu); H[(size_t)c * LDA_G + 64] = (bf16_t)(cvt_pk_bf16(hi, hi) & 0xffffu);
                const float nr = ar * hr - ai * hi + sr[j], ni = ar * hi + ai * hr + si[j]; hr = nr; hi = ni; }
        }
    }
}

__device__ __forceinline__ int crow(int r, int h) { return (r & 3) + 8 * (r >> 2) + 4 * h; }
constexpr int KST = 272, VST = 320;
__device__ __forceinline__ void phase_attn(const Args& a, LAS unsigned char* lds) {
    unsigned char* ws = a.ws; const int tid = tid_fresh(), lane = tid & 63, w = __builtin_amdgcn_readfirstlane(tid >> 6), l31 = lane & 31, h = lane >> 5;
    const bf16_t* Qg = (const bf16_t*)(ws + WS_Q); const bf16_t* Kg = (const bf16_t*)(ws + WS_K); const bf16_t* Vg = (const bf16_t*)(ws + WS_V); bf16_t* YB = (bf16_t*)(ws + WS_YB8);
    LAS unsigned char* Kl = lds; LAS unsigned char* Vl = lds + 64 * KST; LAS float* wsf = (LAS float*)(lds + 64 * KST + 64 * VST) + w * 64;
    unsigned* qctr = (unsigned*)(ws + 32768);
    LAS volatile unsigned* qslot = (LAS volatile unsigned*)(lds + 64 * KST + 64 * VST + 8 * 256);
    for (;;) {
        __syncthreads();
        if (tid == 0) qslot[0] = __hip_atomic_fetch_add(qctr, 1u, __ATOMIC_RELAXED, __HIP_MEMORY_SCOPE_AGENT);
        __syncthreads();
        const int unit = (int)qslot[0];
        if (unit >= 1024) break;
        const int b = unit >> 8, kvh = (unit >> 7) & 1, qb = unit & 127, q0 = qb * 64;
        const int hq = kvh * 4 + (w >> 1), qi = q0 + 32 * (w & 1) + l31;
        const float slope2 = exp2f(-(float)(hq + 1)) * LOG2E;
        bf16x8 qf[8];
#pragma unroll
        for (int ks = 0; ks < 8; ++ks) qf[ks] = *(const bf16x8*)(Qg + (size_t)(b * SEQ + qi) * 1024 + hq * 128 + ks * 16 + h * 8);
        float mrun = a.sink[hq] * LOG2E, lrun = (h == 0) ? 1.0f : 0.0f;
        f32x16 o[4];
#pragma unroll
        for (int d = 0; d < 4; ++d)
#pragma unroll
            for (int r = 0; r < 16; ++r) o[d][r] = 0.f;
        for (int j = 0; j < 6; ++j) {
            const bool meta = (j == 5); const int ks0 = q0 + 64 * (j - 2);
            if (!meta && (ks0 < 0 || ks0 >= SEQ)) continue;
            __syncthreads();
            {
                const int row = tid >> 3, ch = tid & 7; const int nrows = meta ? 16 : 64;
                if (row < nrows) { const size_t grow = meta ? (size_t)(TOK + row) : (size_t)(b * SEQ + ks0 + row);
                    const u32x4* kp = (const u32x4*)(Kg + grow * 256 + kvh * 128); const u32x4* vp = (const u32x4*)(Vg + grow * 256 + kvh * 128);
                    const u32x4 k0 = kp[ch], k1 = kp[ch + 8], v0 = vp[ch], v1 = vp[ch + 8];
                    *(LAS u32x4*)(Kl + row * KST + ch * 16) = k0; *(LAS u32x4*)(Kl + row * KST + (ch + 8) * 16) = k1;
                    *(LAS u32x4*)(Vl + row * VST + ch * 16) = v0; *(LAS u32x4*)(Vl + row * VST + (ch + 8) * 16) = v1; }
            }
            __syncthreads();
            const int nkb = meta ? 1 : 2;
            f32x16 p[2];
#pragma unroll
            for (int kb = 0; kb < 2; ++kb) { if (kb < nkb) {
#pragma unroll
                for (int r = 0; r < 16; ++r) p[kb][r] = 0.f;
#pragma unroll
                for (int ks = 0; ks < 8; ++ks) { const bf16x8 kf = *(const LAS bf16x8*)(Kl + (32 * kb + l31) * KST + (ks * 16 + h * 8) * 2);
                    p[kb] = __builtin_amdgcn_mfma_f32_32x32x16_bf16(kf, qf[ks], p[kb], 0, 0, 0); } } }
            float mt = -1e30f;
#pragma unroll
            for (int kb = 0; kb < 2; ++kb) { if (kb < nkb) {
#pragma unroll
                for (int r = 0; r < 16; ++r) { const int kk = 32 * kb + crow(r, h); float s = p[kb][r];
                    if (meta) { if (kk >= 16) s = -1e30f; }
                    else { const int dlt = ks0 + kk - qi; const int ad = dlt < 0 ? -dlt : dlt; s = (ad <= 128) ? s - slope2 * (float)ad : -1e30f; }
                    p[kb][r] = s; mt = fmaxf(mt, s); } } }
            mt = fmaxf(mt, __shfl_xor(mt, 32));
            const float mnew = fmaxf(mrun, mt), alpha = __builtin_amdgcn_exp2f(mrun - mnew); mrun = mnew;
            float ls = 0.f;
#pragma unroll
            for (int kb = 0; kb < 2; ++kb) { if (kb < nkb) {
#pragma unroll
                for (int r = 0; r < 16; ++r) { const float e = __builtin_amdgcn_exp2f(p[kb][r] - mnew); p[kb][r] = e; ls += e; } } }
            lrun = lrun * alpha + ls;
            if (h == 0) wsf[l31] = alpha;
            LDS_WAIT();
#pragma unroll
            for (int r = 0; r < 16; ++r) { const float al = wsf[crow(r, h)];
#pragma unroll
                for (int d = 0; d < 4; ++d) o[d][r] *= al; }
            const int gi = lane >> 4, i16 = lane & 15;
#pragma unroll
            for (int kb = 0; kb < 2; ++kb) { if (kb < nkb) {
#pragma unroll
                for (int s = 0; s < 2; ++s) { if (meta && s == 1) continue;
                    union { u32x4 u; bf16x8 v; } pa;
                    pa.u.x = cvt_pk_bf16(p[kb][8 * s + 0], p[kb][8 * s + 1]); pa.u.y = cvt_pk_bf16(p[kb][8 * s + 2], p[kb][8 * s + 3]);
                    pa.u.z = cvt_pk_bf16(p[kb][8 * s + 4], p[kb][8 * s + 5]); pa.u.w = cvt_pk_bf16(p[kb][8 * s + 6], p[kb][8 * s + 7]);
                    const int krow = 32 * kb + 16 * s + 4 * h + (i16 >> 2);
#pragma unroll
                    for (int d = 0; d < 4; ++d) {
                        const LAS unsigned char* vp = Vl + krow * VST + (d * 32 + 16 * (gi & 1) + 4 * (i16 & 3)) * 2;
                        const s16x4 lo = __builtin_amdgcn_ds_read_tr16_b64_v4i16((LAS s16x4*)vp);
                        const s16x4 hi = __builtin_amdgcn_ds_read_tr16_b64_v4i16((LAS s16x4*)(vp + 8 * VST));
                        const bf16x8 vb = {lo[0], lo[1], lo[2], lo[3], hi[0], hi[1], hi[2], hi[3]};
                        o[d] = __builtin_amdgcn_mfma_f32_32x32x16_bf16(pa.v, vb, o[d], 0, 0, 0); } } } }
        }
        lrun += __shfl_xor(lrun, 32);
        LDS_WAIT();
        if (h == 0) wsf[l31] = 1.0f / lrun;
        LDS_WAIT();
#pragma unroll
        for (int r = 0; r < 16; ++r) { const int qr = crow(r, h); const float li = wsf[qr];
            bf16_t* orow = (bf16_t*)((unsigned char*)YB + (size_t)(b * SEQ + q0 + 32 * (w & 1) + qr) * 1024 + hq * 128 + l31);
#pragma unroll
            for (int d = 0; d < 4; ++d) ((unsigned char*)orow)[d * 32] = (unsigned char)(__builtin_amdgcn_cvt_pk_fp8_f32(o[d][r] * li, 0.f, 0, false) & 0xff); }
        LDS_WAIT();
    }
    __syncthreads();
}

__device__ __forceinline__ void ce_desc(unsigned& a, unsigned& b) { const unsigned hi = max(a, b), lo = min(a, b); a = hi; b = lo; }
__device__ __forceinline__ void bitonic_merge16(unsigned (&v)[16]) {
#pragma unroll
    for (int j = 8; j > 0; j >>= 1)
#pragma unroll
        for (int i = 0; i < 16; ++i) { const int l = i ^ j; if (l > i) ce_desc(v[i], v[l]); }
}
__device__ __forceinline__ void bitonic_sort16(unsigned (&v)[16]) {
#pragma unroll
    for (int k = 2; k <= 16; k <<= 1)
#pragma unroll
        for (int j = k >> 1; j > 0; j >>= 1)
#pragma unroll
            for (int i = 0; i < 16; ++i) { const int l = i ^ j; if (l > i) { if (((i & k) == 0) || k == 16) ce_desc(v[i], v[l]); else ce_desc(v[l], v[i]); } }
}
__device__ __forceinline__ void top16_merge(unsigned (&r)[16], const unsigned (&g)[16]) {
#pragma unroll
    for (int i = 0; i < 16; ++i) r[i] = max(r[i], g[15 - i]);
    bitonic_merge16(r);
}
__device__ __forceinline__ unsigned f2ord(float f) { const unsigned u = __float_as_uint(f); return u ^ ((u >> 31) ? 0xffffffffu : 0x80000000u); }
template <int NT> __device__ __forceinline__ void x8_group(const Args& a, const int tb, const int lane);
__device__ __forceinline__ int phase_topk(const Args& a, LAS unsigned char* lds) {
    unsigned char* ws = a.ws; const int tid = tid_fresh(), lane = tid & 63, w = __builtin_amdgcn_readfirstlane(tid >> 6), fr = lane & 15, fq = lane >> 4;
    const bf16_t* QP = (const bf16_t*)(ws + WS_QP); const bf16_t* PK = (const bf16_t*)(ws + WS_PK);
    int* EIDX = (int*)(ws + WS_EIDX); float* EGATE = (float*)(ws + WS_EGATE); const float* RSS = (const float*)(ws + WS_RSS);
    constexpr int AST = 528, BST = 272;
    LAS unsigned char* Al = lds; LAS unsigned char* Bl = lds + 128 * AST;
    constexpr int SCP = 261;
    LAS float* sc = (LAS float*)lds;
    LAS unsigned* kl = (LAS unsigned*)(lds + 128 * SCP * 4 + 64);
    u32x4 pfa[8], pfb[8];
#define TK_FETCH(u_) do { const int tt_ = (u_) >> 3, hd_ = (u_) & 7; _Pragma("unroll") for (int q_ = 0; q_ < 8; ++q_) { const int i_ = tid + q_ * NTHREADS; \
        { const int row = i_ >> 5, ch = i_ & 31; pfa[q_] = *(const u32x4*)(QP + (size_t)(tt_ * 128 + row) * 2048 + hd_ * 256 + ch * 8); } \
        { const int row = i_ >> 4, ch = i_ & 15; pfb[q_] = *(const u32x4*)(PK + (size_t)(row >> 7) * 131072 + ((size_t)hd_ * 128 + (row & 127)) * 128 + ch * 8); } } } while (0)
    pg::StaticOrder SO; SO.init(TOK, 2048, (int)gridDim.x, (int)blockIdx.x);
#define TK_UNIT(j_) ({ pg::Unit u_; int r_ = -1; if (SO.next((j_) >> 1, u_)) r_ = (2 * u_.pm + ((j_) & 1)) * 8 + u_.pn; r_; })
    int unit = TK_UNIT(0), jn = 1, ju = 0;
    if (unit >= 0) TK_FETCH(unit);
    for (; unit >= 0; ) {
        const int tt = unit >> 3, hd = unit & 7, t0 = tt * 128;
        __syncthreads();
#pragma unroll
        for (int q_ = 0; q_ < 8; ++q_) { const int i_ = tid + q_ * NTHREADS;
            { const int row = i_ >> 5, ch = i_ & 31; *(LAS u32x4*)(Al + row * AST + ch * 16) = pfa[q_]; }
            { const int row = i_ >> 4, ch = i_ & 15; *(LAS u32x4*)(Bl + row * BST + ch * 16) = pfb[q_]; } }
        __syncthreads();
        const int unit_next = TK_UNIT(jn); ++jn;
        if (unit_next >= 0) TK_FETCH(unit_next);
        f32x4 acc[2][8];
#pragma unroll
        for (int hf = 0; hf < 2; ++hf)
#pragma unroll
            for (int nb = 0; nb < 8; ++nb) acc[hf][nb] = (f32x4){0.f, 0.f, 0.f, 0.f};
#pragma unroll
        for (int hf = 0; hf < 2; ++hf)
#pragma unroll
            for (int ks = 0; ks < 4; ++ks) { const bf16x8 af = *(const LAS bf16x8*)(Al + (16 * w + fr) * AST + (hf * 128 + ks * 32 + fq * 8) * 2);
#pragma unroll
                for (int nb = 0; nb < 8; ++nb) { const bf16x8 bfr = *(const LAS bf16x8*)(Bl + (hf * 128 + nb * 16 + fr) * BST + (ks * 32 + fq * 8) * 2);
                    acc[hf][nb] = __builtin_amdgcn_mfma_f32_16x16x32_bf16(af, bfr, acc[hf][nb], 0, 0, 0); } }
        float rsr[4];
#pragma unroll
        for (int r = 0; r < 4; ++r) { const f32x4* rp = (const f32x4*)(RSS + (size_t)(t0 + 16 * w + 4 * fq + r) * 32); float ssum = 0.f;
#pragma unroll
            for (int j = 0; j < 8; ++j) { const f32x4 t = rp[j]; ssum += (t[0] + t[1]) + (t[2] + t[3]); }
            rsr[r] = 1.0f / sqrtf(ssum * (1.0f / 2048.0f) + NORM_EPS); }
        __syncthreads();
#pragma unroll
        for (int hf = 0; hf < 2; ++hf)
#pragma unroll
            for (int nb = 0; nb < 8; ++nb)
#pragma unroll
                for (int r = 0; r < 4; ++r) sc[(16 * w + 4 * fq + r) * SCP + hf * 128 + nb * 16 + fr] = acc[hf][nb][r] * rsr[r];
        __syncthreads();
        {
            const int tok = 16 * w + (lane & 15), hf = (lane >> 4) & 1, part = lane >> 5; unsigned R[16], Gq[16];
            const LAS float* sp = sc + tok * SCP + hf * 128 + part * 64;
#pragma unroll
            for (int gi = 0; gi < 4; ++gi) {
                int goff = ((gi + (lane >> 4)) & 3) * 16;
                asm volatile("" : "+v"(goff));
                const LAS float* sg = sp + goff; const unsigned ib = (unsigned)(127 - part * 64 - goff);
#pragma unroll
                for (int j = 0; j < 16; ++j) Gq[j] = (f2ord(sg[j]) & ~127u) | (ib - (unsigned)j);
                bitonic_sort16(Gq);
                if (gi == 0) {
#pragma unroll
                    for (int j = 0; j < 16; ++j) R[j] = Gq[j];
                } else top16_merge(R, Gq);
            }
#pragma unroll
            for (int j = 0; j < 16; ++j) Gq[j] = (unsigned)__shfl_xor((int)R[j], 32);
            top16_merge(R, Gq);
            if (part == 0) {
#pragma unroll
                for (int j = 0; j < 16; ++j) kl[(tok * 2 + hf) * 16 + j] = R[j]; }
        }
        __syncthreads();
        if (tid < 128) {
            const int tok = tid; unsigned L[16], Gq[16];
            float v1[16], v2[16];
#pragma unroll
            for (int j = 0; j < 16; ++j) { const int n1 = 127 - (int)(kl[(tok * 2) * 16 + j] & 127u), n2 = 127 - (int)(kl[(tok * 2 + 1) * 16 + j] & 127u);
                v1[j] = sc[tok * SCP + n1]; v2[j] = sc[tok * SCP + 128 + n2]; }
            {
                int cnt = 0, grp = 0;
#pragma unroll
                for (int j = 0; j < 16; ++j) Gq[j] = 0u;
#pragma unroll
                for (int i = 0; i < 16; ++i)
#pragma unroll
                    for (int j = 0; j < 16; ++j) if ((i + 1) * (j + 1) <= 16) {
                        Gq[cnt & 15] = (f2ord(v1[i] + v2[j]) & ~255u) | (unsigned)(255 - (i * 16 + j)); ++cnt;
                        if ((cnt & 15) == 0 || cnt == 50) { bitonic_sort16(Gq);
                            if (grp == 0) {
#pragma unroll
                                for (int q = 0; q < 16; ++q) L[q] = Gq[q];
                            } else top16_merge(L, Gq);
                            ++grp;
#pragma unroll
                            for (int q = 0; q < 16; ++q) Gq[q] = 0u; } }
            }
            float sv[16]; int ei[16]; float mx = -1e30f;
#pragma unroll
            for (int q = 0; q < 16; ++q) { const int ci = 255 - (int)(L[q] & 255u), i = ci >> 4, j = ci & 15;
                const int n1 = 127 - (int)(kl[(tok * 2) * 16 + i] & 127u), n2 = 127 - (int)(kl[(tok * 2 + 1) * 16 + j] & 127u);
                sv[q] = sc[tok * SCP + n1] + sc[tok * SCP + 128 + n2]; ei[q] = n1 * 128 + n2; mx = fmaxf(mx, sv[q]); }
            float sum = 0.f;
#pragma unroll
            for (int q = 0; q < 16; ++q) { sv[q] = __builtin_amdgcn_exp2f((sv[q] - mx) * LOG2E); sum += sv[q]; }
            const float inv = 1.0f / sum; const size_t ob = ((size_t)(t0 + tok) * 8 + hd) * 16;
#pragma unroll
            for (int q = 0; q < 4; ++q) { *(int4*)(EIDX + ob + 4 * q) = make_int4(ei[4 * q], ei[4 * q + 1], ei[4 * q + 2], ei[4 * q + 3]);
                *(f32x4*)(EGATE + ob + 4 * q) = (f32x4){sv[4 * q] * inv, sv[4 * q + 1] * inv, sv[4 * q + 2] * inv, sv[4 * q + 3] * inv}; }
        }
#if X8_IN_TOPK
        else if (w >= 2 && ju < 8) {
            const int tb = blockIdx.x * 128 + (ju * 6 + (w - 2)) * 2; if (tb < TOK) x8_group<2>(a, tb, lane); }
#endif
        ++ju;
        unit = unit_next;
    }
    __syncthreads();
    return ju < 8 ? ju : 8;
}

#define DPP_ROR_ADD(v, n) ((v) + __uint_as_float(__builtin_amdgcn_update_dpp(0, __float_as_uint(v), 0x120 + (n), 0xf, 0xf, false)))
__device__ __forceinline__ float reduce4(float p0, float p1, float p2, float p3) {
    const auto s01 = __builtin_amdgcn_permlane32_swap(__float_as_uint(p0), __float_as_uint(p1), false, false);
    const auto s23 = __builtin_amdgcn_permlane32_swap(__float_as_uint(p2), __float_as_uint(p3), false, false);
    const float r01 = __uint_as_float(s01[0]) + __uint_as_float(s01[1]), r23 = __uint_as_float(s23[0]) + __uint_as_float(s23[1]);
    const auto t = __builtin_amdgcn_permlane16_swap(__float_as_uint(r01), __float_as_uint(r23), false, false);
    float r = __uint_as_float(t[0]) + __uint_as_float(t[1]);
    r = DPP_ROR_ADD(r, 8); r = DPP_ROR_ADD(r, 4); r = DPP_ROR_ADD(r, 2); r = DPP_ROR_ADD(r, 1);
    return r;
}
__device__ __forceinline__ float dot16_fp8(const u32x4 q, const f32x2* h, float acc) {
    f32x2 s = {acc, 0.f};
#pragma unroll
    for (int j = 0; j < 4; ++j) { const unsigned d = q[j]; const f32x2 lo = __builtin_amdgcn_cvt_pk_f32_fp8(d, false), hi = __builtin_amdgcn_cvt_pk_f32_fp8(d, true);
        s = __builtin_elementwise_fma(lo, h[2 * j], s); s = __builtin_elementwise_fma(hi, h[2 * j + 1], s); }
    return s.x + s.y;
}
__device__ __forceinline__ void axpy16_fp8(const u32x4 q, const float w, f32x2* acc) {
    const f32x2 ww = {w, w};
#pragma unroll
    for (int j = 0; j < 4; ++j) { const unsigned d = q[j]; const f32x2 lo = __builtin_amdgcn_cvt_pk_f32_fp8(d, false), hi = __builtin_amdgcn_cvt_pk_f32_fp8(d, true);
        acc[2 * j] = __builtin_elementwise_fma(lo, ww, acc[2 * j]); acc[2 * j + 1] = __builtin_elementwise_fma(hi, ww, acc[2 * j + 1]); }
}
struct Row6 { u32x4 a; u32x2 b; };
__device__ __forceinline__ void axpy32_fp6(const Row6& q, const float w, f32x2* acc) {
    const u32x6 v = {q.a[0], q.a[1], q.a[2], q.a[3], q.b[0], q.b[1]};
    const f32x32 f = FMT6 == 0 ? __builtin_amdgcn_cvt_scalef32_pk32_f32_bf6(v, 1.0f) : __builtin_amdgcn_cvt_scalef32_pk32_f32_fp6(v, 1.0f); const f32x2 ww = {w, w};
#pragma unroll
    for (int j = 0; j < 16; ++j) acc[j] = __builtin_elementwise_fma((f32x2){f[2 * j], f[2 * j + 1]}, ww, acc[j]);
}
struct Row4 { u32x4 q; unsigned s; };
__device__ __forceinline__ void axpy32_fp4(const Row4& r, const float w, f32x2* acc) {
    const float ws_ = w * __uint_as_float((r.s << 20) + ((unsigned)SC4_BIAS << 20)); const float scale = 1.0f; const f32x2 ww = {ws_, ws_};
#pragma unroll
    for (int d = 0; d < 4; ++d) { const unsigned x = r.q[d];
        acc[4 * d + 0] = __builtin_elementwise_fma(__builtin_amdgcn_cvt_scalef32_pk_f32_fp4(x, scale, 0), ww, acc[4 * d + 0]);
        acc[4 * d + 1] = __builtin_elementwise_fma(__builtin_amdgcn_cvt_scalef32_pk_f32_fp4(x, scale, 1), ww, acc[4 * d + 1]);
        acc[4 * d + 2] = __builtin_elementwise_fma(__builtin_amdgcn_cvt_scalef32_pk_f32_fp4(x, scale, 2), ww, acc[4 * d + 2]);
        acc[4 * d + 3] = __builtin_elementwise_fma(__builtin_amdgcn_cvt_scalef32_pk_f32_fp4(x, scale, 3), ww, acc[4 * d + 3]); }
}
__device__ __forceinline__ float dot32_fp4(const Row4& r, const f32x2* h) {
    const float scale = 1.0f;
    f32x2 s0 = {0.f, 0.f}, s1 = {0.f, 0.f};
    asm volatile("" : "+v"(s0), "+v"(s1));
#pragma unroll
    for (int d = 0; d < 4; ++d) { const unsigned x = r.q[d];
        s0 = __builtin_elementwise_fma(__builtin_amdgcn_cvt_scalef32_pk_f32_fp4(x, scale, 0), h[4 * d + 0], s0);
        s1 = __builtin_elementwise_fma(__builtin_amdgcn_cvt_scalef32_pk_f32_fp4(x, scale, 1), h[4 * d + 1], s1);
        s0 = __builtin_elementwise_fma(__builtin_amdgcn_cvt_scalef32_pk_f32_fp4(x, scale, 2), h[4 * d + 2], s0);
        s1 = __builtin_elementwise_fma(__builtin_amdgcn_cvt_scalef32_pk_f32_fp4(x, scale, 3), h[4 * d + 3], s1); }
    return ((s0.x + s0.y) + (s1.x + s1.y)) * __uint_as_float((r.s << 20) + ((unsigned)SC4_BIAS << 20));
}
__device__ __forceinline__ float dot32_fp6(const Row6& q, const f32x2* h) {
    const u32x6 v = {q.a[0], q.a[1], q.a[2], q.a[3], q.b[0], q.b[1]};
    f32x2 s0 = {0.f, 0.f}, s1 = {0.f, 0.f};
    const f32x32 f = FMT6 == 0 ? __builtin_amdgcn_cvt_scalef32_pk32_f32_bf6(v, 1.0f) : __builtin_amdgcn_cvt_scalef32_pk32_f32_fp6(v, 1.0f);
    asm volatile("" : "+v"(s0), "+v"(s1));
#pragma unroll
    for (int j = 0; j < 16; j += 2) { s0 = __builtin_elementwise_fma((f32x2){f[2 * j], f[2 * j + 1]}, h[j], s0); s1 = __builtin_elementwise_fma((f32x2){f[2 * j + 2], f[2 * j + 3]}, h[j + 1], s1); }
    return (s0.x + s0.y) + (s1.x + s1.y);
}

template <int NT> __device__ __forceinline__ void x8_group(const Args& a, const int tb, const int lane) {
    unsigned char* ws = a.ws;
    const bf16_t* H2U = (const bf16_t*)(ws + WS_H2U); const float* RSS = (const float*)(ws + WS_RSS);
    unsigned char* X8G = ws + WS_X8G; float* XSCL = (float*)(ws + WS_XSCL);
    {
        u32x2 raw[NT][8]; float rsq[NT], am[NT];
#pragma unroll
        for (int t = 0; t < NT; ++t) { const size_t tok = (size_t)(tb + t);
#pragma unroll
            for (int j = 0; j < 8; ++j) raw[t][j] = *(const u32x2*)(H2U + tok * 2048 + (j * 64 + lane) * 4);
            rsq[t] = (lane < 32) ? RSS[tok * 32 + lane] : 0.f; }
#pragma unroll
        for (int t = 0; t < NT; ++t) { float m = 0.f;
#pragma unroll
            for (int j = 0; j < 8; ++j) m = fmaxf(m, fmaxf(fmaxf(fabsf(bf_lo(raw[t][j].x)), fabsf(bf_hi(raw[t][j].x))), fmaxf(fabsf(bf_lo(raw[t][j].y)), fabsf(bf_hi(raw[t][j].y)))));
            am[t] = m; }
#pragma unroll
        for (int o = 1; o < 64; o <<= 1) {
#pragma unroll
            for (int t = 0; t < NT; ++t) { am[t] = fmaxf(am[t], __shfl_xor(am[t], o)); rsq[t] += __shfl_xor(rsq[t], o); } }
#pragma unroll
        for (int t = 0; t < NT; ++t) { const size_t tok = (size_t)(tb + t);
            const float rs2 = 1.0f / sqrtf(rsq[t] * (1.0f / 2048.0f) + NORM_EPS);
            float sc = 1.0f, isc = 1.0f;
            if (am[t] > 0.f) { const float e = fminf(fmaxf(floorf(log2f(256.0f / am[t])), -100.f), 100.f); sc = exp2f(e); isc = exp2f(-e); }
            u32x4 w0, w1;
#pragma unroll
            for (int j = 0; j < 8; ++j) { int pk = __builtin_amdgcn_cvt_pk_fp8_f32(bf_lo(raw[t][j].x) * sc, bf_hi(raw[t][j].x) * sc, 0, false);
                pk = __builtin_amdgcn_cvt_pk_fp8_f32(bf_lo(raw[t][j].y) * sc, bf_hi(raw[t][j].y) * sc, pk, true);
                if (j < 4) w0[j] = (unsigned)pk; else w1[j - 4] = (unsigned)pk; }
            *(u32x4*)(X8G + tok * 2048 + lane * 32) = w0; *(u32x4*)(X8G + tok * 2048 + lane * 32 + 16) = w1;
            if (lane == 0) XSCL[tok] = isc * rs2; }
    }
}
__device__ __forceinline__ void phase_x8(const Args& a, const int ju_done) {
    const int tid = tid_fresh(), lane = tid & 63, wave = tid >> 6;
    const int gw = blockIdx.x * NWAVES + wave, NGW = gridDim.x * NWAVES;
#if X8_IN_TOPK
#pragma unroll 1
    for (int pr = ju_done * 6 + wave; pr < 48; pr += NWAVES) { const int tb = blockIdx.x * 128 + pr * 2; if (tb < TOK) x8_group<2>(a, tb, lane); }
    { const int tb = blockIdx.x * 128 + 96 + wave * 4; if (tb < TOK) x8_group<4>(a, tb, lane); }
#pragma unroll 1
    for (int tb = ((int)gridDim.x * 32 + gw) * 4; tb < TOK; tb += NGW * 4) x8_group<4>(a, tb, lane);
#else
#pragma unroll 1
    for (int tb = gw * 4; tb < TOK; tb += NGW * 4) x8_group<4>(a, tb, lane);
#endif
}
#if UFMT4
typedef Row4 RowU;
__device__ __forceinline__ float dot32_u(const Row4& r, const f32x2* h) {
    return dot32_fp4(r, h);
}
__device__ __forceinline__ void g_load_row(Row4& d, const __amdgpu_buffer_rsrc_t rsT, const __amdgpu_buffer_rsrc_t rsS, int lane, int e) {
    d.q = __builtin_amdgcn_raw_buffer_load_b128(rsT, lane * 16, e * 1024, 0); d.s = (unsigned)__builtin_amdgcn_raw_buffer_load_b8(rsS, lane, e * 64, 0); }
#else
typedef Row6 RowU;
__device__ __forceinline__ float dot32_u(const Row6& r, const f32x2* h) { return dot32_fp6(r, h); }
__device__ __forceinline__ void g_load_row(Row6& d, const __amdgpu_buffer_rsrc_t rsT, const __amdgpu_buffer_rsrc_t rsS, int lane, int e) {
    d.a = __builtin_amdgcn_raw_buffer_load_b128(rsT, lane * 16, e * 1536, 0); d.b = __builtin_amdgcn_raw_buffer_load_b64(rsT, 1024 + lane * 8, e * 1536, 0); }
#endif
__device__ __forceinline__ void phase_gather(const Args& a) {
    unsigned char* ws = a.ws; const int tid = tid_fresh(), lane = tid & 63, wave = tid >> 6;
    const bf16_t* H2U = (const bf16_t*)(ws + WS_H2U); const unsigned char* UT = ws + WS_UT; const unsigned char* VT = ws + WS_VT;
    const float* ISU = (const float*)(ws + WS_ISU); const float* ISV = (const float*)(ws + WS_ISV);
    const int* EIDX = (const int*)(ws + WS_EIDX); const float* EGATE = (const float*)(ws + WS_EGATE); const float* RSS = (const float*)(ws + WS_RSS);
    const int gw = blockIdx.x * NWAVES + wave, NGW = gridDim.x * NWAVES;
    const __amdgpu_buffer_rsrc_t rsUT = __builtin_amdgcn_make_buffer_rsrc((void*)UT, 0, 24 << 20, 0x00020000), rsVT = __builtin_amdgcn_make_buffer_rsrc((void*)VT, 0, 16 << 20, 0x00020000), rsVS = __builtin_amdgcn_make_buffer_rsrc((void*)(ws + WS_ISV), 0, 1 << 20, 0x00020000), rsUS = __builtin_amdgcn_make_buffer_rsrc((void*)(ws + WS_ISU), 0, 1 << 20, 0x00020000);
#if DOTS_PROBE
    { const float V = *(const float*)(ws + WS_DOTS);
        for (int tok = gw; tok < TOK; tok += NGW) { float* orow = a.out + (size_t)tok * 2048;
#pragma unroll
            for (int j = 0; j < 8; ++j) *(f32x4*)(orow + (j * 64 + lane) * 4) = (f32x4){V, V, V, V}; }
        return; }
#endif
    if (DBG & 64) {
        const float lv[8] = {0.f, 0.5f, 1.f, 1.5f, 2.f, 3.f, 4.f, 6.f};
        unsigned v1 = 0x76543210u, v2 = 0xFEDCBA98u; asm volatile("" : "+v"(v1), "+v"(v2)); float one = 1.0f, quarter = 0.25f; asm volatile("" : "+v"(one), "+v"(quarter));
        int n1 = 0, n2 = 0, n3 = 0;
#define PB(sel) { const f32x2 a_ = __builtin_amdgcn_cvt_scalef32_pk_f32_fp4(v1, one, sel), b_ = __builtin_amdgcn_cvt_scalef32_pk_f32_fp4(v2, one, sel), c_ = __builtin_amdgcn_cvt_scalef32_pk_f32_fp4(v1, quarter, sel); \
            n1 += (a_.x != lv[2 * sel]) + (a_.y != lv[2 * sel + 1]); n2 += (b_.x != -lv[2 * sel]) + (b_.y != -lv[2 * sel + 1]); n3 += (c_.x != 0.25f * lv[2 * sel]) + (c_.y != 0.25f * lv[2 * sel + 1]); }
        PB(0) PB(1) PB(2) PB(3)
#undef PB
        const float V = sqrtf((float)(n1 + 10 * n2 + 100 * n3));
        for (int tok = gw; tok < TOK; tok += NGW) { float* orow = a.out + (size_t)tok * 2048;
#pragma unroll
            for (int j = 0; j < 8; ++j) *(f32x4*)(orow + (j * 64 + lane) * 4) = (f32x4){V, V, V, V}; }
        return;
    }
    for (int tq = gw * 8; tq < TOK; tq = ((tq & 7) == 7) ? tq - 7 + NGW * 8 : tq + 1) { const int tok = tq;
        float rs2; { float s = (lane < 32) ? RSS[(size_t)tok * 32 + lane] : 0.f; s = wave_sum(s); rs2 = 1.0f / sqrtf(s * (1.0f / 2048.0f) + NORM_EPS); }
        const int e_lo = EIDX[(size_t)tok * 128 + lane], e_hi = EIDX[(size_t)tok * 128 + 64 + lane];
        const float c1_lo = UFMT4 ? rs2 : rs2 * ISU[e_lo], c1_hi = UFMT4 ? rs2 : rs2 * ISU[e_hi];
        const float c2_lo = EGATE[(size_t)tok * 128 + lane], c2_hi = EGATE[(size_t)tok * 128 + 64 + lane];
        float w_lo = 0.f, w_hi = 0.f;
#if MFMA_A
        w_lo = c2_lo * gelu_tanh(((const float*)(ws + WS_DOTS))[(size_t)tok * 128 + lane]); w_hi = c2_hi * gelu_tanh(((const float*)(ws + WS_DOTS))[(size_t)tok * 128 + 64 + lane]);
        (void)c1_lo; (void)c1_hi;
#else
        f32x2 h[16];
#pragma unroll
        for (int j = 0; j < 8; ++j) { const u32x2 q = *(const u32x2*)(H2U + (size_t)tok * 2048 + (j * 64 + lane) * 4); h[2 * j] = (f32x2){bf_lo(q.x), bf_hi(q.x)}; h[2 * j + 1] = (f32x2){bf_lo(q.y), bf_hi(q.y)}; }
#define G_LOAD(dst, TAB, k) do { const int ev_ = (k) < 64 ? e_lo : e_hi; _Pragma("unroll") for (int kk = 0; kk < 8; ++kk) { \
            const int e_ = __builtin_amdgcn_readlane(ev_, ((k) & 63) + kk); g_load_row(dst[kk], rs##TAB, rsUS, lane, e_); } } while (0)
#define G_DOTS(src, k) do { float p[4]; _Pragma("unroll") for (int kk = 0; kk < 4; ++kk) { p[kk] = dot32_u(src[kk], h); __builtin_amdgcn_sched_barrier(0); } \
            const float r0 = reduce4(p[0], p[1], p[2], p[3]); __builtin_amdgcn_sched_barrier(0); \
            _Pragma("unroll") for (int kk = 0; kk < 4; ++kk) { p[kk] = dot32_u(src[4 + kk], h); __builtin_amdgcn_sched_barrier(0); } \
            const float r1 = reduce4(p[0], p[1], p[2], p[3]); float t[8]; \
            t[0] = __uint_as_float(__builtin_amdgcn_readlane(__float_as_uint(r0), 0)); t[2] = __uint_as_float(__builtin_amdgcn_readlane(__float_as_uint(r0), 16)); \
            t[1] = __uint_as_float(__builtin_amdgcn_readlane(__float_as_uint(r0), 32)); t[3] = __uint_as_float(__builtin_amdgcn_readlane(__float_as_uint(r0), 48)); \
            t[4] = __uint_as_float(__builtin_amdgcn_readlane(__float_as_uint(r1), 0)); t[6] = __uint_as_float(__builtin_amdgcn_readlane(__float_as_uint(r1), 16)); \
            t[5] = __uint_as_float(__builtin_amdgcn_readlane(__float_as_uint(r1), 32)); t[7] = __uint_as_float(__builtin_amdgcn_readlane(__float_as_uint(r1), 48)); \
            float nv = 0.f; const int lk = lane - ((k) & 63); _Pragma("unroll") for (int kk = 0; kk < 8; ++kk) nv = (lk == kk) ? t[kk] : nv; \
            if ((k) < 64) { if ((unsigned)lk < 8u) w_lo = nv; } else { if ((unsigned)lk < 8u) w_hi = nv; } } while (0)
#define G_AXPY(src, k) do { const float wv_ = (k) < 64 ? w_lo : w_hi; _Pragma("unroll") for (int kk = 0; kk < 8; ++kk) { \
            const float wk_ = __uint_as_float(__builtin_amdgcn_readlane(__float_as_uint(wv_), ((k) & 63) + kk)); axpy16_fp8(src[kk][0], wk_, acc); axpy16_fp8(src[kk][1], wk_, acc + 8); \
            if ((kk & 1) == 1) __builtin_amdgcn_sched_barrier(0); } } while (0)
        RowU bufA[8], bufB[8];
        G_LOAD(bufA, UT, 0);
#pragma unroll 1
        for (int k0 = 0; k0 < 128; k0 += 16) {
            G_LOAD(bufB, UT, k0 + 8); __builtin_amdgcn_sched_barrier(0);
            G_DOTS(bufA, k0); __builtin_amdgcn_sched_barrier(0);
            if (k0 + 16 < 128) G_LOAD(bufA, UT, k0 + 16);
            __builtin_amdgcn_sched_barrier(0);
            G_DOTS(bufB, k0 + 8); __builtin_amdgcn_sched_barrier(0);
        }
        w_lo = c2_lo * gelu_tanh(w_lo * c1_lo); w_hi = c2_hi * gelu_tanh(w_hi * c1_hi);
#endif
        if (DBG & 2) { w_lo = 0.f; w_hi = 0.f; }
#define V_LOAD(dst, k) do { const int ev_ = (k) < 64 ? e_lo : e_hi; _Pragma("unroll") for (int kk = 0; kk < 8; ++kk) { \
            const int e_ = __builtin_amdgcn_readlane(ev_, ((k) & 63) + kk); dst[kk].q = __builtin_amdgcn_raw_buffer_load_b128(rsVT, lane * 16, e_ * 1024, 0); \
            dst[kk].s = (unsigned)__builtin_amdgcn_raw_buffer_load_b8(rsVS, lane, e_ * 64, 0); } } while (0)
#define V_AXPY(src, k) do { const float wv_ = (k) < 64 ? w_lo : w_hi; _Pragma("unroll") for (int kk = 0; kk < 8; ++kk) { \
            const float wk_ = __uint_as_float(__builtin_amdgcn_readlane(__float_as_uint(wv_), ((k) & 63) + kk)); axpy32_fp4(src[kk], wk_, acc); \
            __builtin_amdgcn_sched_barrier(0); } } while (0)
        f32x2 acc[16];
#pragma unroll
        for (int j = 0; j < 16; ++j) acc[j] = (f32x2){0.f, 0.f};
        Row4 vA[8], vB[8];
        V_LOAD(vA, 0);
#pragma unroll 1
        for (int k0 = 0; k0 < 128; k0 += 16) {
            V_LOAD(vB, k0 + 8); __builtin_amdgcn_sched_barrier(0);
            V_AXPY(vA, k0); __builtin_amdgcn_sched_barrier(0);
            if (k0 + 16 < 128) V_LOAD(vA, k0 + 16);
            __builtin_amdgcn_sched_barrier(0);
            V_AXPY(vB, k0 + 8); __builtin_amdgcn_sched_barrier(0);
        }
#undef V_LOAD
#undef V_AXPY
#undef G_LOAD
#undef G_DOTS
#undef G_AXPY
        float ss = 0.f;
#pragma unroll
        for (int j = 0; j < 8; ++j) { const u32x2 q = *(const u32x2*)(H2U + (size_t)tok * 2048 + (j * 64 + lane) * 4); f32x2& a0 = acc[2 * j]; f32x2& a1 = acc[2 * j + 1];
            a0.x += bf_lo(q.x); a0.y += bf_hi(q.x); a1.x += bf_lo(q.y); a1.y += bf_hi(q.y); ss += (a0.x * a0.x + a0.y * a0.y) + (a1.x * a1.x + a1.y * a1.y); }
        const float rs = 1.0f / sqrtf(wave_sum(ss) * (1.0f / 2048.0f) + NORM_EPS);
        float* orow = a.out + (size_t)tok * 2048;
#pragma unroll
        for (int j = 0; j < 8; ++j) { const f32x4 gq = *(const f32x4*)(a.norm_final + (j * 64 + lane) * 4); const f32x2 a0 = acc[2 * j], a1 = acc[2 * j + 1];
            *(f32x4*)(orow + (j * 64 + lane) * 4) = (f32x4){a0.x * rs * gq[0], a0.y * rs * gq[1], a1.x * rs * gq[2], a1.y * rs * gq[3]}; }
    }
}

#define XB_TMO      128
#define XB_XCNT(j)  (256  + 64 * (j))
#define XB_XSUB(j)  (1280 + 64 * (j))
#define XB_XGEN(j)  (2304 + 64 * (j))
#define XB_TOP      3328
#define XB_TOPGEN   3392
#define XCD_BAR_WORDS 3456
#define XB_SPIN_CAP (1u << 20)
__device__ __forceinline__ unsigned xb_ld(unsigned* p)              { return __hip_atomic_load(p, __ATOMIC_RELAXED, __HIP_MEMORY_SCOPE_AGENT); }
__device__ __forceinline__ unsigned xb_add(unsigned* p, unsigned v) { return __hip_atomic_fetch_add(p, v, __ATOMIC_RELAXED, __HIP_MEMORY_SCOPE_AGENT); }
__device__ __forceinline__ unsigned xb_xcc_id() { return (unsigned)__builtin_amdgcn_s_getreg((3 << 11) | 20) & 0xFu; }
#define XB_SPIN(cond, bar) do { unsigned _sp = 0; while (cond) { __builtin_amdgcn_s_sleep(1); \
    if ((++_sp & 255u) == 0u) { if (xb_ld(&(bar)[XB_TMO])) break; if (_sp > XB_SPIN_CAP) { atomicAdd(&(bar)[XB_TMO], 1u); break; } } } } while (0)
struct XcdBarrier { unsigned* bar; unsigned x; volatile LAS unsigned* st; };
__device__ __forceinline__ XcdBarrier xcd_barrier_post(unsigned* bar, volatile LAS unsigned* st) {
    XcdBarrier b; b.bar = bar; b.x = xb_xcc_id(); b.st = st;
    if (threadIdx.x == 0) (void)xb_add(&bar[XB_XCNT(b.x)], 1u);
    return b;
}
__device__ __forceinline__ void xcd_barrier_complete(unsigned* bar, unsigned x, unsigned& nloc, unsigned& nx) {
    const unsigned G = gridDim.x * gridDim.y * gridDim.z;
    unsigned sum, cnt, mine, sp = 0u;
    for (;;) {
        sum = 0u; cnt = 0u; mine = 0u;
#pragma unroll
        for (unsigned j = 0; j < 16; ++j) { const unsigned c = xb_ld(&bar[XB_XCNT(j)]); sum += c; cnt += (c > 0u) ? 1u : 0u; mine = (j == x) ? c : mine; }
        if (sum == G) break;
        __builtin_amdgcn_s_sleep(1);
        if ((++sp & 255u) == 0u) { if (xb_ld(&bar[XB_TMO])) break; if (sp > XB_SPIN_CAP) { atomicAdd(&bar[XB_TMO], 1u); break; } }
    }
    nloc = mine > 0u ? mine : 1u; nx = cnt > 0u ? cnt : 1u;
}
__device__ __forceinline__ void xcd_barrier(const XcdBarrier& b) {
    asm volatile("s_waitcnt vmcnt(0)" ::: "memory");
    __syncthreads();
    if (threadIdx.x == 0) {
        unsigned* bar = b.bar;
        __builtin_amdgcn_s_waitcnt(0);
        unsigned nloc = b.st[0], nx = b.st[1];
        if (nloc == 0u) { xcd_barrier_complete(bar, b.x, nloc, nx); b.st[0] = nloc; b.st[1] = nx; }
        const unsigned old = xb_add(&bar[XB_XSUB(b.x)], 1u);
        const unsigned gen = old / nloc;
        if (old + 1u == (gen + 1u) * nloc) {
            __builtin_amdgcn_fence(__ATOMIC_RELEASE, "agent");
            asm volatile("s_waitcnt vmcnt(0)" ::: "memory");
            const unsigned og = xb_add(&bar[XB_TOP], 1u);
            const unsigned tg = og / nx;
            if (og + 1u == (tg + 1u) * nx) xb_add(&bar[XB_TOPGEN], 1u);
            else XB_SPIN(xb_ld(&bar[XB_TOPGEN]) == tg, bar);
            __builtin_amdgcn_fence(__ATOMIC_ACQUIRE, "agent");
            xb_add(&bar[XB_XGEN(b.x)], 1u);
            asm volatile("s_waitcnt vmcnt(0)" ::: "memory");
        } else {
            XB_SPIN(xb_ld(&bar[XB_XGEN(b.x)]) == gen, bar);
            __builtin_amdgcn_fence(__ATOMIC_ACQUIRE, "agent");
            asm volatile("s_waitcnt vmcnt(0)" ::: "memory");
        }
    }
    __syncthreads();
}

constexpr int DOT_TS = 2064;
constexpr int DOT_CH = 4;
constexpr int DOT_WAVE_LDS = 19968;
#define DG_BLD(B_, st) { B_[0] = *(const LAS u32x4*)(xb_ + (st) * 128); B_[1] = *(const LAS u32x4*)(xb_ + (st) * 128 + 64); }
#define DG_ALD(dst, vo, off) asm volatile("buffer_load_dwordx4 %0, %1, %2, 0 offen offset:%3" : "=v"(dst) : "v"(vo), "s"(rsUT4), "n"(off) : "memory")
#define DG_SLD(dst, vo) asm volatile("buffer_load_dwordx4 %0, %1, %2, 0 offen" : "=v"(dst) : "v"(vo), "s"(rsUS4) : "memory")
#define DG_PERM(s_, PF) { asm volatile("s_waitcnt vmcnt(%1)" : "+v"(A_[s_]) : "n"((PF) ? 20 : 19 - (s_)) : "memory"); \
        if (tmode & 64) P_[(s_) & 3] = A_[s_]; else { *(LAS u32x4*)stw_ = A_[s_]; P_[(s_) & 3] = *(const LAS u32x4*)str_; }     \
        if ((PF) && !(tmode & 128)) DG_ALD(A_[s_], vo_n, (s_) * 64); }
#define DG_STEP(Bc, Bn, st, PF) { if ((st) < 13 && !(tmode & 64)) DG_BLD(Bn, (st) + 3) if ((st) < 14) DG_PERM((st) + 2, PF) __builtin_amdgcn_sched_barrier(0); \
        if (tmode & 64) { acc_[(st) & 3] += __uint_as_float(P_[(st) & 3][0] ^ P_[(st) & 3][1] ^ P_[(st) & 3][2] ^ P_[(st) & 3][3]); } else \
        { const i32x8 av_ = {(int)P_[(st) & 3][0], (int)P_[(st) & 3][1], (int)P_[(st) & 3][2], (int)P_[(st) & 3][3], 0, 0, 0, 0}; \
          const i32x8 bv_ = {(int)Bc[0][0], (int)Bc[0][1], (int)Bc[0][2], (int)Bc[0][3], (int)Bc[1][0], (int)Bc[1][1], (int)Bc[1][2], (int)Bc[1][3]}; \
          acc_ = __builtin_amdgcn_mfma_scale_f32_16x16x128_f8f6f4(av_, bv_, acc_, 4, 0, (st) & 3, (int)S_[(st) >> 2], 0, 0x7f7f7f7f); } \
        __builtin_amdgcn_sched_barrier(0); }
#if DOTS_PROBE
__device__ __forceinline__ float pr_a4(int c) { return c < 2 ? 0.5f * (float)c : (float)(1 << ((c >> 1) - 1)) * (1.0f + 0.5f * (float)(c & 1)); }
__device__ __forceinline__ int pr_fa(int i, int k) { return (i * 3 + k * 5 + (k >> 4)) & 7; }
__device__ __forceinline__ int pr_fb(int k, int j) { return (k * 7 + j * 3 + (k >> 5)) & 7; }
__device__ __forceinline__ int pr_map(int split, int q, int j) { return split ? (j < 16 ? 16 * q + j : 64 + 16 * q + (j - 16)) : 32 * q + j; }
__device__ __forceinline__ void dots_probe(float* res, int lane) {
    const int r = lane & 15, q = lane >> 4;
    const unsigned long long B8 = 0x4E4C4A4844403800ull;
    float ref[4], ref2[4];
#pragma unroll
    for (int t = 0; t < 4; ++t) { float s1 = 0.f, s2 = 0.f; const int i = 4 * q + t;
        for (int k = 0; k < 128; ++k) { const float p = pr_a4(pr_fa(i, k)) * (float)pr_fb(k, r); s1 += p; s2 += p * (float)(1 << ((i + 2 * (k >> 5)) & 3)); }
        ref[t] = s1; ref2[t] = s2; }
    int d = 0;
#pragma unroll 1
    for (int h = 0; h < 4; ++h) { const int sa = h >> 1, sb = h & 1;
        i32x8 av = {0, 0, 0, 0, 0, 0, 0, 0}, bv = {0, 0, 0, 0, 0, 0, 0, 0};
        unsigned aw[4] = {0u, 0u, 0u, 0u}, bw[8] = {0u, 0u, 0u, 0u, 0u, 0u, 0u, 0u};
#pragma unroll
        for (int j = 0; j < 32; ++j) { aw[j >> 3] |= (unsigned)pr_fa(r, pr_map(sa, q, j)) << (4 * (j & 7)); bw[j >> 2] |= (unsigned)((B8 >> (8 * pr_fb(pr_map(sb, q, j), r))) & 0xffull) << (8 * (j & 3)); }
#pragma unroll
        for (int j = 0; j < 4; ++j) av[j] = (int)aw[j];
#pragma unroll
        for (int j = 0; j < 8; ++j) bv[j] = (int)bw[j];
        f32x4 acc = {0.f, 0.f, 0.f, 0.f};
        acc = __builtin_amdgcn_mfma_scale_f32_16x16x128_f8f6f4(av, bv, acc, 4, 0, 0, 0x7f7f7f7f, 0, 0x7f7f7f7f);
        const bool ok = acc[0] == ref[0] && acc[1] == ref[1] && acc[2] == ref[2] && acc[3] == ref[3];
        if (__ballot(ok) == ~0ull && d == 0) d = h + 1;
        if (h == 0) {
            const int sc = ((127 + ((r + 2 * q) & 3)) << 8) | 130 | (131 << 16) | (125 << 24);
            f32x4 a2 = {0.f, 0.f, 0.f, 0.f};
            a2 = __builtin_amdgcn_mfma_scale_f32_16x16x128_f8f6f4(av, bv, a2, 4, 0, 1, sc, 0, 0x7f7f7f7f);
            const bool ok2 = a2[0] == ref2[0] && a2[1] == ref2[1] && a2[2] == ref2[2] && a2[3] == ref2[3];
            if (__ballot(ok2) == ~0ull) d += 5; }
    }
    if (lane == 0) *res = (float)d;
}
#endif
__device__ __forceinline__ void phase_dots(const Args& a, LAS unsigned char* lds, int ctr_set = 0, int tmode = 0) {
#if DOTS_PROBE
    { if (blockIdx.x == 0 && tid_fresh() < 64) dots_probe((float*)(a.ws + WS_DOTS), tid_fresh() & 63); return; }
#endif
    unsigned char* ws = a.ws; const int tid = tid_fresh(), lane = tid & 63, wave = __builtin_amdgcn_readfirstlane(tid >> 6);
    const bf16_t* H2U = (const bf16_t*)(ws + WS_H2U); const int* EIDX = (const int*)(ws + WS_EIDX); const float* RSS = (const float*)(ws + WS_RSS);
    const unsigned char* X8G = ws + WS_X8G; const float* XSCL = (const float*)(ws + WS_XSCL);
    float* DOTS = (float*)(ws + WS_DOTS); unsigned* ctr = (unsigned*)(ws + 32768 + 512 + 512 * ctr_set);
    LAS unsigned char* X8 = lds + wave * DOT_WAVE_LDS;
    LAS unsigned* LIST = (LAS unsigned*)(X8 + 8 * DOT_TS);
    LAS float* SCL = (LAS float*)(X8 + 8 * DOT_TS + 2048);
    const __amdgpu_buffer_rsrc_t rsUT = __builtin_amdgcn_make_buffer_rsrc((void*)(ws + WS_UT), 0, 16 << 20, 0x00020000), rsUS = __builtin_amdgcn_make_buffer_rsrc((void*)(ws + WS_ISU), 0, 1 << 20, 0x00020000),
        rsD = __builtin_amdgcn_make_buffer_rsrc((void*)(ws + WS_DOTS), 0, 16 << 20, 0x00020000);
    i32x4 rsUT4, rsUS4, rsD4;
    { const unsigned long long pu_ = (unsigned long long)(ws + WS_UT), ps_ = (unsigned long long)(ws + WS_ISU), pd_ = (unsigned long long)(ws + WS_DOTS);
      rsUT4 = (i32x4){__builtin_amdgcn_readfirstlane((int)(unsigned)pu_), __builtin_amdgcn_readfirstlane((int)(unsigned)(pu_ >> 32)), 16 << 20, 0x00020000};
      rsUS4 = (i32x4){__builtin_amdgcn_readfirstlane((int)(unsigned)ps_), __builtin_amdgcn_readfirstlane((int)(unsigned)(ps_ >> 32)), 1 << 20, 0x00020000};
      rsD4 = (i32x4){__builtin_amdgcn_readfirstlane((int)(unsigned)pd_), __builtin_amdgcn_readfirstlane((int)(unsigned)(pd_ >> 32)), 16 << 20, 0x00020000}; }
    const int r = lane & 15, q = lane >> 4;
    LAS unsigned char* stw_ = X8 + 18592 + (lane >> 2) * 64 + (((lane & 3) ^ ((lane >> 4) & 3)) * 16);
    const LAS unsigned char* str_ = X8 + 18592 + r * 64 + ((q ^ ((r >> 2) & 3)) * 16);
    const LAS unsigned char* xb_ = X8 + (r & 7) * DOT_TS + q * 16;
#pragma unroll 1
    for (int it = (int)blockIdx.x * NWAVES + wave; it < TOK / 8; it += (int)gridDim.x * NWAVES) {
        {
            const int tok0 = it * 8;
            i32x4 ev[4];
            {   u32x4 xr[8][2];
#pragma unroll
                for (int t = 0; t < 8; ++t) { xr[t][0] = *(const u32x4*)(X8G + (size_t)(tok0 + t) * 2048 + lane * 32); xr[t][1] = *(const u32x4*)(X8G + (size_t)(tok0 + t) * 2048 + lane * 32 + 16); }
                const float xs = XSCL[tok0 + (lane & 7)];
#pragma unroll
                for (int c = 0; c < 4; ++c) ev[c] = *(const i32x4*)(EIDX + (size_t)tok0 * 128 + c * 256 + lane * 4);
#pragma unroll
                for (int t = 0; t < 8; ++t) { *(LAS u32x4*)(X8 + t * DOT_TS + lane * 32) = xr[t][0]; *(LAS u32x4*)(X8 + t * DOT_TS + lane * 32 + 16) = xr[t][1]; }
                if (lane < 8) SCL[lane] = xs;
            }
#pragma unroll 1
          for (int shard = 0; shard < 8; ++shard) {
            int nall = 0;
#pragma unroll
            for (int c = 0; c < 4; ++c)
#pragma unroll
                for (int j = 0; j < 4; ++j) nall += __builtin_popcountll(__ballot((ev[c][j] >> 11) == shard));
            const int nrounds = nall <= 512 ? 1 : 2;
#pragma unroll 1
            for (int rd = 0; rd < nrounds; ++rd) {
                int n = 0;
#pragma unroll
                for (int c = 0; c < 4; ++c) { if (nrounds == 2 && (c >> 1) != rd) continue;
#pragma unroll
                    for (int j = 0; j < 4; ++j) { const int idx = c * 256 + lane * 4 + j; const bool f = (ev[c][j] >> 11) == shard; const unsigned long long m = __ballot(f);
                        if (f) LIST[n + (int)__builtin_amdgcn_mbcnt_hi((unsigned)(m >> 32), __builtin_amdgcn_mbcnt_lo((unsigned)m, 0u))] = (unsigned)(ev[c][j] & 0x3fff) | ((unsigned)(idx >> 7) << 14) | ((unsigned)(idx & 127) << 18);
                        n += __builtin_popcountll(m); } }
                LDS_WAIT();
                const int ng = (tmode & 2) ? 0 : (n + 15) >> 4;
                const float sclv = SCL[r & 7];
                if (ng > 0) {
                    u32x4 A_[16], S_, Sn_ = {0u, 0u, 0u, 0u}; int vo_n;
                    { const unsigned en_ = LIST[r < n ? r : n - 1], en2_ = LIST[(lane >> 2) < n ? (lane >> 2) : n - 1]; const int e_ = (int)(en_ & ((tmode & 4) ? 0x7fu : 0x3fffu)), e2_ = (int)(en2_ & ((tmode & 4) ? 0x7fu : 0x3fffu));
                      vo_n = e2_ * 1024 + (lane & 3) * 16; const int so_ = e_ * 64 + q * 16;
                      DG_SLD(S_, so_);
                      DG_ALD(A_[0], vo_n, 0); DG_ALD(A_[1], vo_n, 64); DG_ALD(A_[2], vo_n, 128); DG_ALD(A_[3], vo_n, 192); DG_ALD(A_[4], vo_n, 256); DG_ALD(A_[5], vo_n, 320); DG_ALD(A_[6], vo_n, 384); DG_ALD(A_[7], vo_n, 448);
                      DG_ALD(A_[8], vo_n, 512); DG_ALD(A_[9], vo_n, 576); DG_ALD(A_[10], vo_n, 640); DG_ALD(A_[11], vo_n, 704); DG_ALD(A_[12], vo_n, 768); DG_ALD(A_[13], vo_n, 832); DG_ALD(A_[14], vo_n, 896); DG_ALD(A_[15], vo_n, 960);
                      { const int m16_ = -16, z_ = 0;
#pragma unroll
                        for (int j = 0; j < 4; ++j) asm volatile("buffer_store_dword %0, %1, %2, 0 offen" :: "v"(z_), "v"(m16_), "s"(rsD4) : "memory"); }
                      asm volatile("s_waitcnt vmcnt(20)" : "+v"(S_) :: "memory"); }
#define DG_GROUP(PF) { f32x4 acc_ = {0.f, 0.f, 0.f, 0.f}; u32x4 b0_[2], b1_[2], b2_[2], b3_[2], P_[4]; \
                    const u32x4 er_ = *(const LAS u32x4*)(LIST + g * 16 + q * 4); DG_BLD(b0_, 0) DG_PERM(0, PF) DG_BLD(b1_, 1) DG_PERM(1, PF) DG_BLD(b2_, 2) __builtin_amdgcn_sched_barrier(0); \
                    DG_STEP(b0_, b3_, 0, PF) DG_STEP(b1_, b0_, 1, PF) DG_STEP(b2_, b1_, 2, PF) DG_STEP(b3_, b2_, 3, PF) DG_STEP(b0_, b3_, 4, PF) DG_STEP(b1_, b0_, 5, PF) DG_STEP(b2_, b1_, 6, PF) DG_STEP(b3_, b2_, 7, PF) \
                    DG_STEP(b0_, b3_, 8, PF) DG_STEP(b1_, b0_, 9, PF) DG_STEP(b2_, b1_, 10, PF) DG_STEP(b3_, b2_, 11, PF) DG_STEP(b0_, b3_, 12, PF) DG_STEP(b1_, b0_, 13, PF) DG_STEP(b2_, b1_, 14, PF) DG_STEP(b3_, b2_, 15, PF) \
                    _Pragma("unroll") for (int j = 0; j < 4; ++j) { const int ri_ = g * 16 + q * 4 + j; const unsigned en_ = er_[j]; const int ts_ = (int)((en_ >> 14) & 15u); \
                        const bool ok_ = ri_ < n && ts_ == r;       \
                        const float val_ = acc_[j] * sclv; const int off_ = (ok_ && tmode == 0) ? (int)((((unsigned)(tok0 + ts_) << 7) + (en_ >> 18)) << 2) : -16; \
                        asm volatile("buffer_store_dword %0, %1, %2, 0 offen" :: "v"(val_), "v"(off_), "s"(rsD4) : "memory"); } }
#pragma unroll 1
                    for (int g = 0; g < ng - 1; ++g) {
                        { const int ix_ = (g + 1) * 16 + r, ix2_ = (g + 1) * 16 + (lane >> 2); const unsigned en_ = LIST[ix_ < n ? ix_ : n - 1], en2_ = LIST[ix2_ < n ? ix2_ : n - 1];
                          const int e_ = (int)(en_ & ((tmode & 4) ? 0x7fu : 0x3fffu)), e2_ = (int)(en2_ & ((tmode & 4) ? 0x7fu : 0x3fffu)); vo_n = e2_ * 1024 + (lane & 3) * 16; const int so_ = e_ * 64 + q * 16;
                          DG_SLD(Sn_, so_); }
                        DG_GROUP(true)
                        asm volatile("s_waitcnt vmcnt(20)" : "+v"(Sn_) :: "memory");
                        S_ = Sn_;
                    }
                    { const int g = ng - 1; DG_GROUP(false) }
#undef DG_GROUP
                }
                LDS_WAIT();
            }
          }
        }
    }
}
#undef DG_STEP
#undef DG_PERM
#undef DG_BLD
#undef DG_ALD
#undef DG_SLD

constexpr int N_PHASES = 13;
template <int LO, int HI> __global__ void __launch_bounds__(NTHREADS, 2) fwd_kernel(Args a_in) {
    extern __shared__ __attribute__((aligned(16))) unsigned char lds_raw[];
    LAS unsigned char* lds = (LAS unsigned char*)lds_raw;
    const int G = gridDim.x;
#if defined(__HIP_DEVICE_COMPILE__)
    typedef const __attribute__((address_space(4))) Args* KArgsPtr;
    KArgsPtr kap = (KArgsPtr)__builtin_amdgcn_kernarg_segment_ptr();
#define PHASE_ARGS() KArgsPtr kp_ = kap; asm volatile("" : "+s"(kp_)); const Args a = *kp_; unsigned char* ws = a.ws; (void)ws
#else
#define PHASE_ARGS() const Args a = a_in; unsigned char* ws = a.ws; (void)ws
#endif
#define IN(k) (LO <= (k) && (k) < HI)
    XcdBarrier xbar; xbar.bar = nullptr; xbar.x = 0; xbar.st = nullptr;
    if constexpr (HI - LO > 1) {
        volatile LAS unsigned* misc = (volatile LAS unsigned*)(lds + LDS_BYTES - 256);
        if (threadIdx.x < 2) misc[threadIdx.x] = 0u;
        __syncthreads();
        xbar = xcd_barrier_post((unsigned*)(a_in.ws) + 1024, misc);
    }
#define SEAM(k) do { if constexpr (IN(k) && IN((k) + 1)) { xcd_barrier(xbar); } } while (0)
    if constexpr (IN(0)) { PHASE_ARGS(); phase0(a, lds); } SEAM(0);
    if constexpr (IN(1)) { PHASE_ARGS();
        pg::Desc d{}; pg::desc_seg(d, 0, ws + WS_HA8, 1024, 0, ws + WS_WG8, 1024, 0, 1024); d.nt[1] = 0; d.toep = 0;
        pg::StaticOrder S; S.init(TOK, IN_COLS, G, (int)blockIdx.x);
        EpiG1 E{ws, a.b_gate};
        pg::gemm_phase<EpiG1, pg::StaticOrder, false, true>(lds, d, S, E);
    } SEAM(1);
    if constexpr (IN(2)) { PHASE_ARGS();
        pg::Desc d{}; pg::desc_seg(d, 0, ws + WS_AG, LDA_G, (long)NCHUNK * LDA_G * 2, ws + WS_PT, 1024, (long)256 * 1024 * 2, 1024); d.nt[1] = 0; d.toep = 0;
        pg::GroupOrder S{2, 1, 64, G, (int)blockIdx.x};
        EpiG2 E{(float*)(ws + WS_S)};
        pg::gemm_phase<EpiG2, pg::GroupOrder, false>(lds, d, S, E);
        if ((int)blockIdx.x < 128 && G >= 128) {
            asm volatile("s_waitcnt vmcnt(0)" ::: "memory"); __syncthreads();
            __builtin_amdgcn_fence(__ATOMIC_ACQUIRE, "agent"); asm volatile("s_waitcnt vmcnt(0)" ::: "memory");
            scan_unit(a, (int)blockIdx.x >> 1, (int)blockIdx.x & 1);
        } else if (G < 128) { for (int L = blockIdx.x; L < 128; L += G) { asm volatile("s_waitcnt vmcnt(0)" ::: "memory"); __syncthreads(); __builtin_amdgcn_fence(__ATOMIC_ACQUIRE, "agent"); asm volatile("s_waitcnt vmcnt(0)" ::: "memory"); scan_unit(a, L >> 1, L & 1); } }
        phase_attn(a, lds);
    } SEAM(2);
    if constexpr (IN(4)) { PHASE_ARGS();
        pg::Desc d{}; pg::desc_seg(d, 0, ws + WS_AG, LDA_G, (long)NCHUNK * LDA_G * 2, ws + WS_KTAB + (63 * 256 - 768) * 2, 0, (long)128 * 256 * 2, 1024);
        d.kB[0] = -2048; d.hB[0] = 4096; d.tB[0] = 8192; d.toep = 1;
        pg::desc_seg(d, 1, ws + WS_AG + 1024 * 2, LDA_G, (long)NCHUNK * LDA_G * 2, ws + WS_QT, 256, (long)1024 * 256 * 2, 256);
        pg::GroupOrder S{2, 4, 64, G, (int)blockIdx.x};
        EpiG3 E{(const bf16_t*)(ws + WS_AG), a.ssm_d, (bf16_t*)(ws + WS_YAPRE)};
        pg::gemm_phase<EpiG3, pg::GroupOrder, true>(lds, d, S, E);
    } SEAM(4);
    if constexpr (IN(5)) { PHASE_ARGS();
        pg::Desc d{}; pg::desc_seg(d, 0, ws + WS_YAPRE, 1024, 0, ws + WS_WGLU, 1024, 0, 1024); d.nt[1] = 0; d.toep = 0;
        pg::StaticOrder S; S.init(TOK, 1024, G, (int)blockIdx.x);
        EpiBf<0> E{(bf16_t*)(ws + WS_YA8), 1024, (const bf16_t*)(ws + WS_YAPRE), 1024, nullptr, a.b_glu, nullptr};
        pg::gemm_phase<EpiBf<0>, pg::StaticOrder, false>(lds, d, S, E);
    } SEAM(5);
    if constexpr (IN(6)) { PHASE_ARGS();
        pg::Desc d{}; pg::desc_seg(d, 0, ws + WS_YA8, 512, 0, ws + WS_WP8, 512, 0, 512); d.nt[1] = 0; d.toep = 0;
        pg::StaticOrder S; S.init(TOK, 2048, G, (int)blockIdx.x);
        EpiBf<1> E{(bf16_t*)(ws + WS_M0), 2048, nullptr, 0, (const bf16_t*)(ws + WS_GATES), nullptr, nullptr};
        pg::gemm_phase<EpiBf<1>, pg::StaticOrder, false, true>(lds, d, S, E);
    }
    if constexpr (IN(7)) { PHASE_ARGS();
        pg::Desc d{}; pg::desc_seg(d, 0, ws + WS_YB8, 512, 0, ws + WS_WP8 + 2048 * 1024, 512, 0, 512); d.nt[1] = 0; d.toep = 0;
        pg::StaticOrder S; S.init(TOK, 2048, G, (int)blockIdx.x);
        EpiBf<2> E{(bf16_t*)(ws + WS_MERGED), 2048, (const bf16_t*)(ws + WS_M0), 2048, (const bf16_t*)(ws + WS_GATES), nullptr, nullptr};
        pg::gemm_phase<EpiBf<2>, pg::StaticOrder, false, true>(lds, d, S, E);
    } SEAM(7);
    if constexpr (IN(8)) { PHASE_ARGS();
        pg::Desc d{}; pg::desc_seg(d, 0, ws + WS_MERGED, 1024, 0, ws + WS_WOUT, 1024, 0, 1024); d.nt[1] = 0; d.toep = 0;
        pg::StaticOrder S; S.init(TOK, 2048, G, (int)blockIdx.x);
        EpiG6 E{a.x, (bf16_t*)(ws + WS_H2U), (float*)(ws + WS_RSS)};
        pg::gemm_phase<EpiG6, pg::StaticOrder, false, true>(lds, d, S, E);
    } SEAM(8);
    if constexpr (IN(9)) { PHASE_ARGS();
        pg::Desc d{}; pg::desc_seg(d, 0, ws + WS_H2U, 2048, 0, ws + WS_WQ, 2048, 0, 2048); d.nt[1] = 0; d.toep = 0;
        pg::StaticOrder S; S.init(TOK, 2048, G, (int)blockIdx.x);
        EpiBf<3> E{(bf16_t*)(ws + WS_QP), 2048, nullptr, 0, nullptr, nullptr, (const float*)(ws + WS_RSS)};
        pg::gemm_phase<EpiBf<3>, pg::StaticOrder, false>(lds, d, S, E);
        asm volatile("s_waitcnt vmcnt(0)" ::: "memory"); __syncthreads(); __builtin_amdgcn_fence(__ATOMIC_ACQUIRE, "agent"); asm volatile("s_waitcnt vmcnt(0)" ::: "memory");
    }
    if constexpr (IN(10)) { PHASE_ARGS(); const int ju_ = phase_topk(a, lds); if (MFMA_A) phase_x8(a, ju_); } SEAM(10);
    if constexpr (IN(11)) { PHASE_ARGS(); if (MFMA_A) phase_dots(a, lds);
#if TIME_DOTS
        xcd_barrier(xbar); phase_dots(a, lds, 1, TIME_DOTS);
#endif
        asm volatile("s_waitcnt vmcnt(0)" ::: "memory"); __builtin_amdgcn_fence(__ATOMIC_ACQUIRE, "agent"); asm volatile("s_waitcnt vmcnt(0)" ::: "memory");
    }
    if constexpr (IN(12)) { PHASE_ARGS(); phase_gather(a); }
#undef IN
#undef SEAM
}

#if MK_N_LAUNCHES == 1
constexpr int NK = 1;
static const void* kfun(int) { return (const void*)fwd_kernel<0, N_PHASES>; }
#else
constexpr int NK = N_PHASES;
static const void* kfun(int p) {
    switch (p) { case 0: return (const void*)fwd_kernel<0, 1>; case 1: return (const void*)fwd_kernel<1, 2>; case 2: return (const void*)fwd_kernel<2, 3>; case 3: return (const void*)fwd_kernel<3, 4>;
        case 4: return (const void*)fwd_kernel<4, 5>; case 5: return (const void*)fwd_kernel<5, 6>; case 6: return (const void*)fwd_kernel<6, 7>; case 7: return (const void*)fwd_kernel<7, 8>;
        case 8: return (const void*)fwd_kernel<8, 9>; case 9: return (const void*)fwd_kernel<9, 10>; case 10: return (const void*)fwd_kernel<10, 11>; case 11: return (const void*)fwd_kernel<11, 12>; default: return (const void*)fwd_kernel<12, 13>; }
}
#endif
extern "C" void kernel_launch(void* const* d_in, const int* in_sizes, int n_in, void* d_out, int out_size, void* d_ws, size_t ws_size, hipStream_t stream) {
    static int grid = 0;
    if (grid == 0) {
        if (n_in != 26 || out_size != TOK * D_MODEL || ws_size < WS_END) { fprintf(stderr, "kernel_launch: unexpected shapes n_in %d out %d ws %zu\n", n_in, out_size, ws_size); grid = -1; return; }
        int dev = 0, cus = 0, per_cu = 0;
        if (hipGetDevice(&dev) != hipSuccess || hipDeviceGetAttribute(&cus, hipDeviceAttributeMultiprocessorCount, dev) != hipSuccess) { grid = -1; return; }
        for (int p = 0; p < NK; ++p) if (hipFuncSetAttribute(kfun(p), hipFuncAttributeMaxDynamicSharedMemorySize, LDS_BYTES) != hipSuccess) { fprintf(stderr, "kernel_launch: hipFuncSetAttribute failed\n"); grid = -1; return; }
        if (hipOccupancyMaxActiveBlocksPerMultiprocessor(&per_cu, kfun(0), NTHREADS, LDS_BYTES) != hipSuccess || per_cu < 1) { fprintf(stderr, "kernel_launch: occupancy query says %d\n", per_cu); per_cu = 1; }
        (void)hipGetLastError();
        grid = cus;
        fprintf(stderr, "kernel_launch: cus %d per_cu %d grid %d ws %zu\n", cus, per_cu, grid, ws_size);
    }
    if (grid < 0) return;
    Args a{};
    const float* const* in = (const float* const*)d_in;
    a.x = in[0]; a.meta = in[1]; a.norm_mix = in[2]; a.w_in = in[3]; a.b_gate = in[4]; a.lam_re = in[5]; a.lam_im = in[6]; a.log_dt = in[7];
    a.b_re = in[8]; a.b_im = in[9]; a.c_re = in[10]; a.c_im = in[11]; a.ssm_d = in[12]; a.w_glu = in[13]; a.b_glu = in[14]; a.sink = in[15];
    a.w_ps = in[16]; a.w_pa = in[17]; a.w_out = in[18]; a.norm_ffn = in[19]; a.w_q = in[20]; a.pk1 = in[21]; a.pk2 = in[22]; a.pu = in[23]; a.pv = in[24]; a.norm_final = in[25];
    a.out = (float*)d_out; a.ws = (unsigned char*)d_ws;
#if MK_N_LAUNCHES == 1
    a.ph_lo = 0; a.ph_hi = N_PHASES;
    if (hipMemsetAsync(d_ws, 0, 65536, stream) != hipSuccess) { fprintf(stderr, "kernel_launch: memset of the barrier words failed\n"); return; }
    void* args[] = {&a};
    hipError_t e = hipLaunchCooperativeKernel(kfun(0), dim3(grid), dim3(NTHREADS), args, LDS_BYTES, stream);
    if (e != hipSuccess) fprintf(stderr, "kernel_launch: cooperative launch failed: %s\n", hipGetErrorString(e));
#else
    (void)hipMemsetAsync(d_ws, 0, 65536, stream);
    for (int p = 0; p < N_PHASES; ++p) { a.ph_lo = p; a.ph_hi = p + 1; void* args[] = {&a};
        hipError_t e = hipLaunchKernel(kfun(p), dim3(grid), dim3(NTHREADS), args, LDS_BYTES, stream);
        if (e != hipSuccess) fprintf(stderr, "kernel_launch: launch %d failed: %s\n", p, hipGetErrorString(e));
        if ((REP_MASK >> p) & 1) (void)hipLaunchKernel(kfun(p), dim3(grid), dim3(NTHREADS), args, LDS_BYTES, stream); }
#endif
}
```
